# Optimizing an MI355X kernel written in HIP

```python
import math
import jax, jax.numpy as jnp
from jax import lax
import numpy as np

D_MODEL = 1024
BATCH = 8
SEQ = 4096
DEPTH = 1

CHUNK = 64
RMS_EPS = 1e-6
GN_EPS = 1e-5
RET_HEAD_DIM = 256
RET_HEADS = D_MODEL // RET_HEAD_DIM
RET_WIDTH = RET_HEADS * RET_HEAD_DIM
RET_THETA = 10000.0
DIFF_HEAD_DIM = 64
DIFF_HEADS = D_MODEL // (2 * DIFF_HEAD_DIM)
DIFF_QK_WIDTH = 2 * DIFF_HEADS * DIFF_HEAD_DIM
DIFF_V_WIDTH = DIFF_HEADS * 2 * DIFF_HEAD_DIM
DIFF_ROT_DIM = DIFF_HEAD_DIM // 4
ROPE_THETA = 500000.0
Q_BLOCK = 128
SPLIT_SIZES = (RET_WIDTH, RET_WIDTH, RET_WIDTH, RET_WIDTH,
               DIFF_QK_WIDTH, DIFF_QK_WIDTH, DIFF_V_WIDTH, DIFF_V_WIDTH,
               D_MODEL, D_MODEL)
IN_WIDTH = sum(SPLIT_SIZES)
SPLIT_POINTS = tuple(int(s) for s in np.cumsum(SPLIT_SIZES)[:-1])

kernel_name = 'hybrid_retention_diffattn_gated_block'


def rms_norm(x, g):
    xf = x.astype(jnp.float32)
    y = xf * lax.rsqrt(jnp.mean(xf * xf, axis=-1, keepdims=True) + RMS_EPS)
    return (y * g.astype(jnp.float32)).astype(x.dtype)


def rope(x, pos, rot_dim, theta):
    half = rot_dim // 2
    inv_freq = theta ** (-jnp.arange(half, dtype=jnp.float32) * 2.0 / rot_dim)
    ang = pos.astype(jnp.float32)[:, :, None] * inv_freq
    cos = jnp.cos(ang)[:, :, None, :].astype(x.dtype)
    sin = jnp.sin(ang)[:, :, None, :].astype(x.dtype)
    x1 = x[..., :half]
    x2 = x[..., half:rot_dim]
    return jnp.concatenate([x1 * cos - x2 * sin, x2 * cos + x1 * sin, x[..., rot_dim:]], axis=-1)


def retention(q, k, v, pos, norm_g):
    B, S, H, d = q.shape
    N = S // CHUNK
    f32 = jnp.float32
    q = rope(q.astype(f32), pos, d, RET_THETA)
    k = rope(k.astype(f32), pos, d, RET_THETA) * (d ** -0.5)
    v = v.astype(f32)
    log_gamma = jnp.log1p(-jnp.exp(jnp.linspace(math.log(1.0 / 32), math.log(1.0 / 512), H, dtype=f32)))
    idx = jnp.arange(CHUNK, dtype=f32)
    decay_intra = jnp.exp(jnp.abs(idx[:, None] - idx[None, :])[None] * log_gamma[:, None, None])
    xi = jnp.exp((idx + 1.0)[None] * log_gamma[:, None])
    zeta = jnp.exp((CHUNK - 1.0 - idx)[None] * log_gamma[:, None])
    g_chunk = jnp.exp(CHUNK * log_gamma)

    def to_chunks(t):
        return t.reshape(B, N, CHUNK, H, d).transpose(1, 0, 3, 2, 4)

    qc, kc, vc = to_chunks(q), to_chunks(k), to_chunks(v)
    scores = jnp.einsum('nbhcd,nbhmd->nbhcm', qc, kc) * decay_intra[None, None]
    intra = jnp.einsum('nbhcm,nbhmd->nbhcd', scores, vc)

    def step(state, inp):
        q_n, k_n, v_n = inp
        inter = jnp.einsum('bhcd,bhde->bhce', q_n, state) * xi[None, :, :, None]
        state = state * g_chunk[None, :, None, None] + jnp.einsum(
            'bhcd,bhce->bhde', k_n * zeta[None, :, :, None], v_n)
        return state, inter

    state0 = jnp.zeros((B, H, d, d), f32)
    _, inter = lax.scan(step, state0, (qc, kc, vc))
    o = intra + inter
    mu = jnp.mean(o, axis=-1, keepdims=True)
    var = jnp.mean(jnp.square(o - mu), axis=-1, keepdims=True)
    o = (o - mu) * lax.rsqrt(var + GN_EPS)
    o = o.transpose(1, 0, 3, 2, 4).reshape(B, S, H * d) * norm_g.astype(f32)
    return o


def diff_attention(q, k, v, pos, lq1, lk1, lq2, lk2, subln_g, lambda_init):
    B, S, _ = q.shape
    H, hd = DIFF_HEADS, DIFF_HEAD_DIM
    f32 = jnp.float32
    q = rope(q.reshape(B, S, 2 * H, hd), pos, DIFF_ROT_DIM, ROPE_THETA) * (hd ** -0.5)
    k = rope(k.reshape(B, S, 2 * H, hd), pos, DIFF_ROT_DIM, ROPE_THETA)
    q = q.transpose(0, 2, 1, 3)
    k = k.transpose(0, 2, 1, 3)
    v = v.reshape(B, S, H, 2 * hd).transpose(0, 2, 1, 3)
    lam = (jnp.exp(jnp.sum(lq1.astype(f32) * lk1.astype(f32)))
           - jnp.exp(jnp.sum(lq2.astype(f32) * lk2.astype(f32))) + lambda_init)
    key_chunk = jnp.arange(S) // CHUNK

    def attend_block(blk):
        start = blk * Q_BLOCK
        qb = lax.dynamic_slice_in_dim(q, start, Q_BLOCK, axis=2)
        s = jnp.einsum('bhqd,bhkd->bhqk', qb, k).astype(f32)
        q_chunk = (start + jnp.arange(Q_BLOCK)) // CHUNK
        s = jnp.where(key_chunk[None, :] <= q_chunk[:, None], s, -jnp.inf)
        p = jax.nn.softmax(s, axis=-1).reshape(B, H, 2, Q_BLOCK, S)
        a = p[:, :, 0] - lam * p[:, :, 1]
        return jnp.einsum('bhqk,bhkd->bhqd', a.astype(v.dtype), v)

    o = lax.map(attend_block, jnp.arange(S // Q_BLOCK))
    o = o.transpose(1, 0, 3, 2, 4).reshape(B, S, H, 2 * hd)
    o = rms_norm(o, subln_g) * (1.0 - lambda_init)
    return o.reshape(B, S, H * 2 * hd)


def setup_inputs(seed: int = 0) -> dict:
    key = jax.random.key(seed)
    ks = jax.random.split(key, 20)
    f32 = jnp.float32
    D = D_MODEL

    def nrm(k, shape, scale):
        return jax.random.normal(k, shape, f32) * scale

    x = jax.random.normal(ks[0], (BATCH, SEQ, D), f32)
    c = jax.random.normal(ks[1], (BATCH, D), f32)
    offsets = jax.random.randint(ks[2], (BATCH, 1), 0, 64, dtype=jnp.int32) * CHUNK
    positions = (offsets + jnp.arange(SEQ, dtype=jnp.int32)[None, :]).astype(jnp.int32)
    return {
        'x': x,
        'c': c,
        'positions': positions,
        'ada_w': nrm(ks[3], (DEPTH, D, 3 * D), D ** -0.5),
        'ada_b': nrm(ks[4], (DEPTH, 3 * D), 0.01),
        'pre_norm_g': 1.0 + nrm(ks[5], (DEPTH, D), 0.02),
        'w_in': nrm(ks[6], (DEPTH, D, IN_WIDTH), D ** -0.5),
        'ret_norm_g': 1.0 + nrm(ks[7], (DEPTH, RET_WIDTH), 0.02),
        'diff_lambda_q1': nrm(ks[8], (DEPTH, DIFF_HEAD_DIM), 0.1),
        'diff_lambda_k1': nrm(ks[9], (DEPTH, DIFF_HEAD_DIM), 0.1),
        'diff_lambda_q2': nrm(ks[10], (DEPTH, DIFF_HEAD_DIM), 0.1),
        'diff_lambda_k2': nrm(ks[11], (DEPTH, DIFF_HEAD_DIM), 0.1),
        'diff_subln_g': 1.0 + nrm(ks[12], (DEPTH, 2 * DIFF_HEAD_DIM), 0.02),
        'w_branch_ret': nrm(ks[13], (DEPTH, RET_WIDTH, D), RET_WIDTH ** -0.5),
        'w_branch_diff': nrm(ks[14], (DEPTH, DIFF_V_WIDTH, D), DIFF_V_WIDTH ** -0.5),
        'w_out': nrm(ks[15], (DEPTH, D, D), D ** -0.5),
        'post_norm_g': 1.0 + nrm(ks[16], (DEPTH, D), 0.02),
    }


def reference(x, c, positions, ada_w, ada_b, pre_norm_g, w_in, ret_norm_g,
              diff_lambda_q1, diff_lambda_k1, diff_lambda_q2, diff_lambda_k2,
              diff_subln_g, w_branch_ret, w_branch_diff, w_out, post_norm_g):
    B, S, D = x.shape
    for l in range(DEPTH):
        lambda_init = 0.8 - 0.6 * math.exp(-0.3 * l)
        mod = jax.nn.silu(c) @ ada_w[l] + ada_b[l]
        shift, scale, gate = jnp.split(mod, 3, axis=-1)
        h = rms_norm(x, pre_norm_g[l]) * (1.0 + scale[:, None, :]) + shift[:, None, :]
        proj = h @ w_in[l]
        (rq, rk, rv, rg, dq, dk, dv, dg, m_ret, m_diff) = jnp.split(proj, SPLIT_POINTS, axis=-1)

        y_ret = retention(rq.reshape(B, S, RET_HEADS, RET_HEAD_DIM),
                          rk.reshape(B, S, RET_HEADS, RET_HEAD_DIM),
                          rv.reshape(B, S, RET_HEADS, RET_HEAD_DIM),
                          positions, ret_norm_g[l]).astype(x.dtype)
        y_ret = y_ret * jax.nn.silu(rg)

        y_diff = diff_attention(dq, dk, dv, positions,
                                diff_lambda_q1[l], diff_lambda_k1[l],
                                diff_lambda_q2[l], diff_lambda_k2[l],
                                diff_subln_g[l], lambda_init).astype(x.dtype)
        y_diff = y_diff * jax.nn.silu(dg)

        merged = (jax.nn.sigmoid(m_ret) * (y_ret @ w_branch_ret[l])
                  + jax.nn.sigmoid(m_diff) * (y_diff @ w_branch_diff[l]))
        out = merged @ w_out[l]
        x = x + gate[:, None, :] * rms_norm(out, post_norm_g[l])
    return x
```

```cpp
#include <hip/hip_runtime.h>
#include <hip/hip_cooperative_groups.h>
#include <cstdio>
#include <cstdint>
namespace cg = cooperative_groups;

#define TIDTAB_OFF (147456 - 64)
__device__ __forceinline__ int hw_wave_slot() { return (int)(__builtin_amdgcn_s_getreg((5 << 11) | 4) & 63u); }
__device__ __forceinline__ int lane_now() { int l; asm volatile("v_mbcnt_lo_u32_b32 %0, -1, 0\n\tv_mbcnt_hi_u32_b32 %0, -1, %0" : "=v"(l)); return l; }
__device__ __forceinline__ int tid_now() {
    extern __shared__ __attribute__((aligned(16))) unsigned char lds_raw[];
    const int w = __builtin_amdgcn_readfirstlane((int)((volatile __attribute__((address_space(3))) unsigned char*)lds_raw)[TIDTAB_OFF + hw_wave_slot()]);
    return w * 64 + lane_now();
}
namespace pg8 {
#define PG8_LAS __attribute__((address_space(3)))
typedef unsigned short bf16_t;
typedef short bf16x8 __attribute__((ext_vector_type(8)));
typedef float f32x4 __attribute__((ext_vector_type(4)));
typedef unsigned u32x4 __attribute__((ext_vector_type(4)));
constexpr int BM = 256, BK = 64, HALF = 128, HTB = HALF * BK * 2  , STAGE_BYTES = 8 * HTB, NXCD = 8, WGM = 8;

__host__ __device__ __forceinline__ int lds_byte(int r, int c) { const int st = (r >> 4) * 2 + (c >> 5), rr = r & 15, cc = c & 31, ob = rr * 64 + cc * 2; return st * 1024 + (ob ^ (((ob >> 9) & 1) << 5)); }
__host__ __device__ __forceinline__ void stage_rc(int b, int& R, int& C) { const int st = b / 1024, sb = b % 1024, swz = sb ^ (((sb >> 9) & 1) << 5); R = (st >> 1) * 16 + swz / 64; C = (st & 1) * 32 + (swz % 64) / 2; }
__host__ __device__ __forceinline__ int perm32(int rho) { const int n = rho >> 4, i = rho & 15; return 8 * (i >> 2) + 4 * n + (i & 3); }

struct Unit { int pm, pn; };
struct Gemm { const bf16_t* A; const bf16_t* Bt; int M, N, K; };

struct StaticOrder {
    int nM, nN, nwg, G, c;
    __host__ __device__ void init(int M, int N, int G_, int c_) { nM = M / BM; nN = N / BM; nwg = nM * nN; G = G_; c = c_; }
    __host__ __device__ bool next(int i, Unit& u) const {
        const long L = (long)i * G + c; if (L >= nwg) return false;
        int wgid = (int)L; { const int q = nwg / NXCD, r = nwg % NXCD, xcd = wgid % NXCD, off = wgid / NXCD; wgid = (xcd < r ? xcd * (q + 1) : r * (q + 1) + (xcd - r) * q) + off; }
        const int nig = WGM * nN, gid = wgid / nig, fm = gid * WGM, gsz = (nM - fm) < WGM ? (nM - fm) : WGM;
        u.pm = fm + ((wgid % nig) % gsz); u.pn = (wgid % nig) / gsz; return true;
    }
    __device__ __forceinline__ void a_ready(const Unit&) const {}
    __device__ __forceinline__ void done(const Unit&) const {}
};


typedef float f32x2_t __attribute__((ext_vector_type(2))); typedef __bf16 bf16x2_t __attribute__((ext_vector_type(2)));
__device__ __forceinline__ unsigned cvt_pk_bf16(float lo, float hi) { f32x2_t v = {lo, hi}; bf16x2_t b = __builtin_convertvector(v, bf16x2_t); return __builtin_bit_cast(unsigned, b); }
__device__ __forceinline__ float bf_lo(unsigned w) { return __uint_as_float(w << 16); }
__device__ __forceinline__ float bf_hi(unsigned w) { return __uint_as_float(w & 0xffff0000u); }
__device__ __forceinline__ float sigmoid_f(float x) { return __builtin_amdgcn_rcpf(1.0f + __builtin_amdgcn_exp2f(-1.4426950408889634f * x)); }
__device__ __forceinline__ float silu_f(float x) { return x * sigmoid_f(x); }
__device__ __forceinline__ float sigmoid_l2(float xl2) { return __builtin_amdgcn_rcpf(1.0f + __builtin_amdgcn_exp2f(-xl2)); }
__device__ __forceinline__ u32x4 pack8(const f32x4 v0, const f32x4 v1) { u32x4 w; w.x = cvt_pk_bf16(v0[0], v0[1]); w.y = cvt_pk_bf16(v0[2], v0[3]); w.z = cvt_pk_bf16(v1[0], v1[1]); w.w = cvt_pk_bf16(v1[2], v1[3]); return w; }

struct EpiInProj {
    static constexpr bool PERM = true, AFTER_DRAIN = false;
    static constexpr int NPRE = 2;
    struct Pre { int pv[2]; };
    bf16_t *o0, *o1, *o2, *o3, *o4, *o5, *o6, *o7; const int* pos;
    __device__ __forceinline__ void pre(Pre& P, const Unit& u, int wr, int fr_fq_lane) const {
#pragma unroll
        for (int ai = 0; ai < 2; ++ai) P.pv[ai] = pos[u.pm * BM + ai * HALF + wr * 64 + fr_fq_lane];
    }
    __device__ __forceinline__ void operator()(const f32x4 (&acc)[2][2][4][2], const Unit& u, int wr, int wc, int fr, int fq, const Pre& P) const {
        const int grp = u.pn >> 2, colt = (u.pn & 3) * 256;
        bf16_t* base = grp == 0 ? o0 : grp == 1 ? o1 : grp == 2 ? o2 : grp == 3 ? o3 : grp == 4 ? o4 : grp == 5 ? o5 : grp == 6 ? o6 : o7;
        const int row0 = u.pm * BM + wr * 64 + fr, col0 = colt + wc * 32 + 8 * fq;
        float pp[2][4];
#pragma unroll
        for (int ai = 0; ai < 2; ++ai)
#pragma unroll
            for (int m = 0; m < 4; ++m) pp[ai][m] = (float)__shfl(P.pv[ai], 16 * m + fr);
        if (grp <= 1) {
            float fq8[8];
#pragma unroll
            for (int e = 0; e < 8; ++e) fq8[e] = __builtin_amdgcn_exp2f(-(float)(wc * 32 + 8 * fq + e) * (13.287712379549449f / 128.0f)) * 0.15915494309189535f;
#pragma unroll
            for (int ai = 0; ai < 2; ++ai)
#pragma unroll
                for (int m = 0; m < 4; ++m) {
                    const int row = row0 + ai * HALF + m * 16; const float p = pp[ai][m];
                    f32x4 a0, a1, b0, b1;
#pragma unroll
                    for (int n = 0; n < 2; ++n)
#pragma unroll
                        for (int j = 0; j < 4; ++j) {
                            const float rev = __builtin_amdgcn_fractf(p * fq8[n * 4 + j]);
                            const float sn = __builtin_amdgcn_sinf(rev), cs = __builtin_amdgcn_cosf(rev);
                            const float x1 = acc[ai][0][m][n][j], x2 = acc[ai][1][m][n][j];
                            const float y1 = x1 * cs - x2 * sn, y2 = x2 * cs + x1 * sn;
                            if (n == 0) { a0[j] = y1; b0[j] = y2; } else { a1[j] = y1; b1[j] = y2; }
                        }
                    bf16_t* rowp = base + (size_t)row * 1024 + col0;
                    __builtin_nontemporal_store(pack8(a0, a1), (u32x4*)(rowp)); __builtin_nontemporal_store(pack8(b0, b1), (u32x4*)(rowp + HALF));
                }
        } else if (grp == 4 || grp == 5) {
            const float sc = grp == 4 ? 0.125f * 1.4426950408889634f : 1.0f;
            const bool rot = ((wc & 1) == 0) && (fq < 2);
            float f4[4];
#pragma unroll
            for (int j = 0; j < 4; ++j) f4[j] = __builtin_amdgcn_exp2f(-(float)(4 * (fq & 1) + j) * (18.931568569324174f / 8.0f)) * 0.15915494309189535f;
#pragma unroll
            for (int ai = 0; ai < 2; ++ai)
#pragma unroll
                for (int m = 0; m < 4; ++m) {
                    const int row = row0 + ai * HALF + m * 16; const float p = pp[ai][m];
                    float cs[4], sn[4];
#pragma unroll
                    for (int j = 0; j < 4; ++j) { const float rev = __builtin_amdgcn_fractf(p * f4[j]); sn[j] = rot ? __builtin_amdgcn_sinf(rev) : 0.0f; cs[j] = rot ? __builtin_amdgcn_cosf(rev) : 1.0f; }
                    bf16_t* rowp = (grp == 5) ? base + ((size_t)((row >> 12) * 8 + (colt >> 7)) * 4096 + (row & 4095)) * 128 + wc * 32 + 8 * fq : base + (size_t)row * 1024 + col0;
                    const size_t bjstep = (grp == 5) ? (size_t)4096 * 128 : (size_t)HALF;
#pragma unroll
                    for (int bj = 0; bj < 2; ++bj) {
                        f32x4 v0, v1;
#pragma unroll
                        for (int j = 0; j < 4; ++j) { const float x1 = acc[ai][bj][m][0][j], x2 = acc[ai][bj][m][1][j];
                            v0[j] = (rot ? (x1 * cs[j] - x2 * sn[j]) : x1) * sc; v1[j] = (rot ? (x2 * cs[j] + x1 * sn[j]) : x2) * sc; }
                        __builtin_nontemporal_store(pack8(v0, v1), (u32x4*)(rowp + bj * bjstep));
                    }
                }
        } else {
            const bool act = (grp == 3) || (grp == 7);
#pragma unroll
            for (int ai = 0; ai < 2; ++ai)
#pragma unroll
                for (int m = 0; m < 4; ++m) { const int row = row0 + ai * HALF + m * 16;
                    bf16_t* rowp = (grp == 6) ? base + ((size_t)((row >> 12) * 8 + (colt >> 7)) * 4096 + (row & 4095)) * 128 + wc * 32 + 8 * fq : base + (size_t)row * 1024 + col0;
                    const size_t bjstep = (grp == 6) ? (size_t)4096 * 128 : (size_t)HALF;
#pragma unroll
                    for (int bj = 0; bj < 2; ++bj) { f32x4 v0 = acc[ai][bj][m][0], v1 = acc[ai][bj][m][1];
                        if (act) {
#pragma unroll
                            for (int j = 0; j < 4; ++j) { v0[j] = silu_f(v0[j]); v1[j] = silu_f(v1[j]); } }
                        __builtin_nontemporal_store(pack8(v0, v1), (u32x4*)(rowp + bj * bjstep)); } }
        }
    }
};
struct EpiSigmoid {
    static constexpr bool PERM = true, AFTER_DRAIN = false;
    static constexpr int NPRE = 0; struct Pre {}; __device__ __forceinline__ void pre(Pre&, const Unit&, int, int) const {}
    bf16_t *g0, *g1;
    __device__ __forceinline__ void operator()(const f32x4 (&acc)[2][2][4][2], const Unit& u, int wr, int wc, int fr, int fq, const Pre&) const {
        bf16_t* base = (u.pn >> 2) ? g1 : g0; const int colt = (u.pn & 3) * 256;
        const int row0 = u.pm * BM + wr * 64 + fr, col0 = colt + wc * 32 + 8 * fq;
#pragma unroll
        for (int ai = 0; ai < 2; ++ai)
#pragma unroll
            for (int m = 0; m < 4; ++m) { bf16_t* rowp = base + (size_t)(row0 + ai * HALF + m * 16) * 1024 + col0;
#pragma unroll
                for (int bj = 0; bj < 2; ++bj) { f32x4 v0 = acc[ai][bj][m][0], v1 = acc[ai][bj][m][1];
#pragma unroll
                    for (int j = 0; j < 4; ++j) { v0[j] = sigmoid_l2(v0[j]); v1[j] = sigmoid_l2(v1[j]); }
                    *(u32x4*)(rowp + bj * HALF) = pack8(v0, v1); } }
    }
};
template <bool ADD> struct EpiGate {
    static constexpr bool PERM = true, AFTER_DRAIN = false;
    static constexpr int NPRE = 0; struct Pre {}; __device__ __forceinline__ void pre(Pre&, const Unit&, int, int) const {}
    const bf16_t* G; const bf16_t* T; bf16_t* O;
    __device__ __forceinline__ void operator()(const f32x4 (&acc)[2][2][4][2], const Unit& u, int wr, int wc, int fr, int fq, const Pre&) const {
        const int row0 = u.pm * BM + wr * 64 + fr, col0 = u.pn * BM + wc * 32 + 8 * fq;
        f32x4 r[2][2][4][2];
        if (!ADD) {
            u32x4 gv[2][4][2];
#pragma unroll
            for (int ai = 0; ai < 2; ++ai)
#pragma unroll
                for (int m = 0; m < 4; ++m)
#pragma unroll
                    for (int bj = 0; bj < 2; ++bj) gv[ai][m][bj] = *(const u32x4*)(G + (size_t)(row0 + ai * HALF + m * 16) * 1024 + col0 + bj * HALF);
#pragma unroll
            for (int ai = 0; ai < 2; ++ai)
#pragma unroll
                for (int m = 0; m < 4; ++m)
#pragma unroll
                    for (int bj = 0; bj < 2; ++bj) { const u32x4 g = gv[ai][m][bj]; f32x4 v0 = acc[ai][bj][m][0], v1 = acc[ai][bj][m][1];
                        v0[0] *= bf_lo(g.x); v0[1] *= bf_hi(g.x); v0[2] *= bf_lo(g.y); v0[3] *= bf_hi(g.y);
                        v1[0] *= bf_lo(g.z); v1[1] *= bf_hi(g.z); v1[2] *= bf_lo(g.w); v1[3] *= bf_hi(g.w);
                        r[ai][bj][m][0] = v0; r[ai][bj][m][1] = v1; }
        } else {
#pragma unroll
            for (int ai = 0; ai < 2; ++ai) {
                u32x4 gv[4][2], tv[4][2];
#pragma unroll
                for (int m = 0; m < 4; ++m)
#pragma unroll
                    for (int bj = 0; bj < 2; ++bj) { const size_t off = (size_t)(row0 + ai * HALF + m * 16) * 1024 + col0 + bj * HALF; gv[m][bj] = *(const u32x4*)(G + off); tv[m][bj] = *(const u32x4*)(T + off); }
#pragma unroll
                for (int m = 0; m < 4; ++m)
#pragma unroll
                    for (int bj = 0; bj < 2; ++bj) { const u32x4 g = gv[m][bj], t = tv[m][bj]; f32x4 v0 = acc[ai][bj][m][0], v1 = acc[ai][bj][m][1];
                        v0[0] = v0[0] * bf_lo(g.x) + bf_lo(t.x); v0[1] = v0[1] * bf_hi(g.x) + bf_hi(t.x); v0[2] = v0[2] * bf_lo(g.y) + bf_lo(t.y); v0[3] = v0[3] * bf_hi(g.y) + bf_hi(t.y);
                        v1[0] = v1[0] * bf_lo(g.z) + bf_lo(t.z); v1[1] = v1[1] * bf_hi(g.z) + bf_hi(t.z); v1[2] = v1[2] * bf_lo(g.w) + bf_lo(t.w); v1[3] = v1[3] * bf_hi(g.w) + bf_hi(t.w);
                        r[ai][bj][m][0] = v0; r[ai][bj][m][1] = v1; }
                asm volatile("" ::: "memory");
            }
        }
        asm volatile("" ::: "memory");
#pragma unroll
        for (int ai = 0; ai < 2; ++ai)
#pragma unroll
            for (int m = 0; m < 4; ++m)
#pragma unroll
                for (int bj = 0; bj < 2; ++bj) *(u32x4*)(O + (size_t)(row0 + ai * HALF + m * 16) * 1024 + col0 + bj * HALF) = pack8(r[ai][bj][m][0], r[ai][bj][m][1]);
    }
};
struct EpiOutSsq {
    static constexpr bool PERM = true, AFTER_DRAIN = false;
    static constexpr int NPRE = 0; struct Pre {}; __device__ __forceinline__ void pre(Pre&, const Unit&, int, int) const {}
    bf16_t* O; float* ssq;
    __device__ __forceinline__ void operator()(const f32x4 (&acc)[2][2][4][2], const Unit& u, int wr, int wc, int fr, int fq, const Pre&) const {
        const int row0 = u.pm * BM + wr * 64 + fr, col0 = u.pn * BM + wc * 32 + 8 * fq;
#pragma unroll
        for (int ai = 0; ai < 2; ++ai)
#pragma unroll
            for (int m = 0; m < 4; ++m) { const int row = row0 + ai * HALF + m * 16; const size_t off = (size_t)row * 1024 + col0; float s = 0.f;
#pragma unroll
                for (int bj = 0; bj < 2; ++bj) { const f32x4 v0 = acc[ai][bj][m][0], v1 = acc[ai][bj][m][1];
                    s += (v0[0] * v0[0] + v0[1] * v0[1]) + (v0[2] * v0[2] + v0[3] * v0[3]) + (v1[0] * v1[0] + v1[1] * v1[1]) + (v1[2] * v1[2] + v1[3] * v1[3]);
                    *(u32x4*)(O + off + bj * HALF) = pack8(v0, v1); }
                s += __shfl_xor(s, 16); s += __shfl_xor(s, 32);
                if (fq == 0) ssq[(size_t)row * 16 + u.pn * 4 + wc] = s; }
    }
};

template <class Epi, class Sched, bool ALIGN_EPI = false, bool SP2 = false>
__device__ __forceinline__ void gemm_phase(PG8_LAS unsigned char* lds, const Gemm g, const Sched& S, const Epi& E) {
    int tid_ = tid_now(); asm volatile("" : "+v"(tid_));
    const int tid = tid_, wid = __builtin_amdgcn_readfirstlane(tid >> 6), lane = tid & 63, wr = wid >> 2, wc = wid & 3, fr = lane & 15, fq = lane >> 4;
    const int K = g.K, nt = K / BK;
    unsigned voffA[2], voffB[2];
#pragma unroll
    for (int i = 0; i < 2; ++i) { int R, C; stage_rc(tid * 16 + i * 8192, R, C); const int Rb = Epi::PERM ? ((R & ~31) + perm32(R & 31)) : R;
        voffA[i] = (unsigned)(R * K + C) * 2u; voffB[i] = (unsigned)(Rb * K + C) * 2u; }
    const size_t kstep = (size_t)(BK * 2);
    const size_t hstep = (size_t)HALF * K * 2;
    const size_t tstep = 2 * hstep;
    const unsigned ldsw = (unsigned)wid * 1024u;
    const int aoff = lds_byte(wr * 64 + fr, fq * 8), boff = lds_byte(wc * 32 + fr, fq * 8);
#define PG8_SA(b, h) (((b) * 2 + (h)) * HTB)
#define PG8_SB(b, h) ((4 + (b) * 2 + (h)) * HTB)
#define PG8_STAGE(bufoff, gbase, voff) do { _Pragma("unroll") for (int _i = 0; _i < 2; ++_i) \
        __builtin_amdgcn_global_load_lds((const unsigned*)((const char*)(gbase) + (voff)[_i]), (PG8_LAS unsigned*)(lds + (bufoff) + ldsw + _i * 8192), 16, 0, 0); } while (0)
#define PG8_LDA(dst, b, h) do { _Pragma("unroll") for (int m = 0; m < 4; ++m) _Pragma("unroll") for (int k = 0; k < 2; ++k) dst[m][k] = *(const PG8_LAS bf16x8*)(lds + PG8_SA(b, h) + aoff + m * 2048 + k * 1024); } while (0)
#define PG8_LDB(dst, b, h) do { _Pragma("unroll") for (int n = 0; n < 2; ++n) _Pragma("unroll") for (int k = 0; k < 2; ++k) dst[n][k] = *(const PG8_LAS bf16x8*)(lds + PG8_SB(b, h) + boff + n * 2048 + k * 1024); } while (0)
#define PG8_MMA(ai, bj, At, Bt) do { __builtin_amdgcn_s_setprio(1); _Pragma("unroll") for (int m = 0; m < 4; ++m) _Pragma("unroll") for (int n = 0; n < 2; ++n) _Pragma("unroll") for (int k = 0; k < 2; ++k) \
        acc[ai][bj][m][n] = __builtin_amdgcn_mfma_f32_16x16x32_bf16(Bt[n][k], At[m][k], acc[ai][bj][m][n], 0, 0, 0); __builtin_amdgcn_s_setprio(0); } while (0)
#define PG8_WAIT_V(n) asm volatile("s_waitcnt vmcnt(" #n ")" ::: "memory")
#define PG8_WAIT_L(n) asm volatile("s_waitcnt lgkmcnt(" #n ")" ::: "memory")
#define PG8_BAR __builtin_amdgcn_s_barrier()
#define PG8_SCHED __builtin_amdgcn_sched_barrier(0)
    Unit cur, nxt; int ui = 0;
    if (!S.next(0, cur)) return;
    typename Epi::Pre pre{};
    f32x4 acc[2][2][4][2];
#pragma unroll
    for (int a = 0; a < 2; ++a)
#pragma unroll
        for (int b = 0; b < 2; ++b)
#pragma unroll
            for (int m = 0; m < 4; ++m)
#pragma unroll
                for (int n = 0; n < 2; ++n) acc[a][b][m][n] = (f32x4){0.f, 0.f, 0.f, 0.f};
    bf16x8 At[4][2], B0[2][2], B1[2][2];
    const char* cA = (const char*)g.A + (size_t)cur.pm * tstep; const char* cB = (const char*)g.Bt + (size_t)cur.pn * tstep;
    S.a_ready(cur);
    if constexpr (SP2) {
        PG8_STAGE(PG8_SB(0, 0), cB, voffB); PG8_STAGE(PG8_SB(0, 1), cB + hstep, voffB); PG8_STAGE(PG8_SA(0, 0), cA, voffA); PG8_STAGE(PG8_SA(0, 1), cA + hstep, voffA);
        if (wr == 1) PG8_BAR;
        PG8_WAIT_V(2); PG8_BAR;
        PG8_STAGE(PG8_SB(1, 0), cB + kstep, voffB); PG8_STAGE(PG8_SA(1, 0), cA + kstep, voffA); PG8_STAGE(PG8_SB(1, 1), cB + hstep + kstep, voffB);
        PG8_WAIT_V(6); PG8_BAR;
    } else {
        PG8_STAGE(PG8_SB(0, 0), cB, voffB); PG8_STAGE(PG8_SA(0, 0), cA, voffA); PG8_STAGE(PG8_SB(0, 1), cB + hstep, voffB); PG8_STAGE(PG8_SA(0, 1), cA + hstep, voffA);
        if (wr == 1) PG8_BAR;
        PG8_WAIT_V(4); PG8_BAR;
        PG8_STAGE(PG8_SB(1, 0), cB + kstep, voffB); PG8_STAGE(PG8_SA(1, 0), cA + kstep, voffA); PG8_STAGE(PG8_SB(1, 1), cB + hstep + kstep, voffB);
        PG8_WAIT_V(6); PG8_BAR;
    }
    for (;;) {
        const bool has_next = S.next(ui + 1, nxt);
        const char* nA = has_next ? (const char*)g.A + (size_t)nxt.pm * tstep : cA; const char* nB = has_next ? (const char*)g.Bt + (size_t)nxt.pn * tstep : cB;
        for (int t = 0; t < nt; t += 2) {
            const bool last = (t == nt - 2);
            const char* a1 = cA + (size_t)(t + 1) * kstep;
            const char* a2 = last ? nA : cA + (size_t)(t + 2) * kstep; const char* b2 = last ? nB : cB + (size_t)(t + 2) * kstep;
            const char* a3 = a2 + kstep; const char* b3 = b2 + kstep;
            if (last && has_next) S.a_ready(nxt);
            if constexpr (SP2) {
            PG8_LDB(B0, 0, 0); PG8_LDB(B1, 0, 1); PG8_SCHED; PG8_LDA(At, 0, 0);
            if (Epi::NPRE > 0 && last) E.pre(pre, cur, wr, lane);
            PG8_STAGE(PG8_SA(1, 1), a1 + hstep, voffA);
            if (Epi::NPRE > 0 && last) asm volatile("s_waitcnt vmcnt(%0)" :: "n"(8 + Epi::NPRE) : "memory"); else PG8_WAIT_V(8);
            PG8_WAIT_L(0); PG8_BAR; PG8_MMA(0, 0, At, B0); PG8_MMA(0, 1, At, B1); PG8_BAR; PG8_SCHED;
            PG8_LDA(At, 0, 1); PG8_STAGE(PG8_SB(0, 0), b2, voffB); PG8_STAGE(PG8_SB(0, 1), b2 + hstep, voffB); PG8_STAGE(PG8_SA(0, 0), a2, voffA);
            PG8_WAIT_V(8); PG8_WAIT_L(0); PG8_BAR; PG8_MMA(1, 0, At, B0); PG8_MMA(1, 1, At, B1); PG8_BAR; PG8_SCHED;
            PG8_LDB(B0, 1, 0); PG8_LDB(B1, 1, 1); PG8_SCHED; PG8_LDA(At, 1, 0); PG8_STAGE(PG8_SA(0, 1), a2 + hstep, voffA);
            PG8_WAIT_V(8); PG8_WAIT_L(0); PG8_BAR; PG8_MMA(0, 0, At, B0); PG8_MMA(0, 1, At, B1); PG8_BAR; PG8_SCHED;
            PG8_LDA(At, 1, 1); PG8_STAGE(PG8_SB(1, 0), b3, voffB); PG8_STAGE(PG8_SB(1, 1), b3 + hstep, voffB); PG8_STAGE(PG8_SA(1, 0), a3, voffA);
            PG8_WAIT_V(8); PG8_WAIT_L(0); PG8_BAR; PG8_MMA(1, 0, At, B0); PG8_MMA(1, 1, At, B1); PG8_BAR; PG8_SCHED;
            } else {
            PG8_LDB(B0, 0, 0); PG8_SCHED; PG8_LDA(At, 0, 0); PG8_STAGE(PG8_SA(1, 1), a1 + hstep, voffA);
            PG8_WAIT_L(8); PG8_BAR; PG8_WAIT_L(0); PG8_MMA(0, 0, At, B0); PG8_BAR; PG8_SCHED;
            PG8_LDB(B1, 0, 1); PG8_STAGE(PG8_SB(0, 0), b2, voffB);
            PG8_BAR; PG8_WAIT_L(0); PG8_MMA(0, 1, At, B1); PG8_BAR;
            PG8_LDA(At, 0, 1); PG8_STAGE(PG8_SA(0, 0), a2, voffA);
            PG8_BAR; PG8_WAIT_L(0); PG8_MMA(1, 0, At, B0); PG8_BAR; PG8_SCHED;
            PG8_STAGE(PG8_SB(0, 1), b2 + hstep, voffB);
            PG8_WAIT_V(6); PG8_BAR; PG8_MMA(1, 1, At, B1); PG8_BAR;
            PG8_LDB(B0, 1, 0); PG8_SCHED; PG8_LDA(At, 1, 0); PG8_STAGE(PG8_SA(0, 1), a2 + hstep, voffA);
            PG8_WAIT_L(8); PG8_BAR; PG8_WAIT_L(0); PG8_MMA(0, 0, At, B0); PG8_BAR; PG8_SCHED;
            PG8_LDB(B1, 1, 1); PG8_STAGE(PG8_SB(1, 0), b3, voffB);
            PG8_BAR; PG8_WAIT_L(0); PG8_MMA(0, 1, At, B1); PG8_BAR;
            PG8_LDA(At, 1, 1); PG8_STAGE(PG8_SA(1, 0), a3, voffA);
            PG8_BAR; PG8_WAIT_L(0); PG8_MMA(1, 0, At, B0); PG8_BAR; PG8_SCHED;
            PG8_STAGE(PG8_SB(1, 1), b3 + hstep, voffB);
            PG8_WAIT_V(6); PG8_BAR; PG8_MMA(1, 1, At, B1); PG8_BAR;
            }
        }
        if constexpr (ALIGN_EPI) { if (wr == 0) PG8_BAR; }
        if constexpr (!Epi::AFTER_DRAIN) { E(acc, cur, wr, wc, fr, fq, pre); S.done(cur); }
        if (!has_next) break;
#pragma unroll
        for (int a = 0; a < 2; ++a)
#pragma unroll
            for (int b = 0; b < 2; ++b)
#pragma unroll
                for (int m = 0; m < 4; ++m)
#pragma unroll
                    for (int n = 0; n < 2; ++n) acc[a][b][m][n] = (f32x4){0.f, 0.f, 0.f, 0.f};
        cur = nxt; cA = nA; cB = nB; ++ui;
        if constexpr (ALIGN_EPI) { if (wr == 1) PG8_BAR; }
    }
    PG8_WAIT_V(0);
    if constexpr (!ALIGN_EPI) { if (wr == 0) PG8_BAR; }
    PG8_BAR;
    if constexpr (Epi::AFTER_DRAIN) { E.fused(acc, cur, wr, wc, fr, fq, lds, wid, lane); S.done(cur); }
#undef PG8_SA
#undef PG8_SB
#undef PG8_STAGE
#undef PG8_LDA
#undef PG8_LDB
#undef PG8_MMA
#undef PG8_WAIT_V
#undef PG8_WAIT_L
#undef PG8_BAR
#undef PG8_SCHED
}
}

constexpr int NWAVES = 8, NTHREADS = 512;
constexpr int D = 1024, BATCH = 8, SEQ = 4096, M = BATCH * SEQ, CHUNK = 64;
constexpr int NPROJ = 10240, NMIX = 8192, NGATE = 2048;
constexpr size_t MiB = 1u << 20;
constexpr size_t WS_CTL = 0, CTL_BYTES = 32768;
constexpr int CW_BAR = 1024;
constexpr size_t WS_MODP = 1 * MiB;
constexpr size_t WS_WIN = 4 * MiB;
constexpr size_t WS_WR = 24 * MiB, WS_WD = 26 * MiB, WS_WO = 28 * MiB;
constexpr size_t WS_SSQ = 30 * MiB;
constexpr size_t WS_H = 32 * MiB;
constexpr size_t WS_RQ = 96 * MiB;
constexpr size_t WS_RK = 160 * MiB;
constexpr size_t WS_RV = 224 * MiB;
constexpr size_t WS_RG = 288 * MiB;
constexpr size_t WS_DQ = 352 * MiB;
constexpr size_t WS_DK = 416 * MiB;
constexpr size_t WS_END = 480 * MiB;
constexpr int REP_P0 = 1, REP_P1 = 1, REP_P2 = 1, REP_P4 = 1, REP_P5 = 1, REP_P6 = 1, REP_P7 = 1;
constexpr int LDS_BYTES = 147456;

#define LAS __attribute__((address_space(3)))
typedef unsigned short bf16;
typedef short bf16x8 __attribute__((ext_vector_type(8)));
typedef short s16x4 __attribute__((ext_vector_type(4)));
typedef float f32x4 __attribute__((ext_vector_type(4)));
typedef float f32x16 __attribute__((ext_vector_type(16)));
typedef unsigned u32x4 __attribute__((ext_vector_type(4)));
typedef unsigned u32x2 __attribute__((ext_vector_type(2)));
typedef short v4i16_t __attribute__((ext_vector_type(4)));

__device__ __forceinline__ unsigned f2bf(float f) { unsigned u = __builtin_bit_cast(unsigned, f); return (u + 0x7fffu + ((u >> 16) & 1u)) >> 16; }
__device__ __forceinline__ unsigned pk2(float lo, float hi) { return f2bf(lo) | (f2bf(hi) << 16); }
__device__ __forceinline__ unsigned cvtpk(float lo, float hi) { return pg8::cvt_pk_bf16(lo, hi); }
__device__ __forceinline__ float bflo(unsigned w) { return __uint_as_float(w << 16); }
__device__ __forceinline__ float bfhi(unsigned w) { return __uint_as_float(w & 0xffff0000u); }
__device__ __forceinline__ int crow(int r, int hi) { return (r & 3) + 8 * (r >> 2) + 4 * hi; }
__device__ __forceinline__ s16x4 tr_read(const LAS unsigned char* p) { return __builtin_bit_cast(s16x4, __builtin_amdgcn_ds_read_tr16_b64_v4i16((LAS v4i16_t*)p)); }
__device__ __forceinline__ bf16x8 cat8(s16x4 lo, s16x4 hi) { return (bf16x8){lo[0], lo[1], lo[2], lo[3], hi[0], hi[1], hi[2], hi[3]}; }
__device__ __forceinline__ float wave_sum(float v) {
    const int ln = lane_now();
#pragma unroll
    for (int o = 1; o < 64; o <<= 1) v += __uint_as_float((unsigned)__builtin_amdgcn_ds_bpermute((ln ^ o) << 2, (int)__float_as_uint(v)));
    return v;
}

struct Args {
    const float* x; const float* c; const int* pos; const float* ada_w; const float* ada_b; const float* pre_g; const float* w_in; const float* ret_g;
    const float* lq1; const float* lk1; const float* lq2; const float* lk2; const float* subln_g; const float* w_br; const float* w_bd; const float* w_out; const float* post_g;
    float* out; unsigned char* ws;
};

#define XB_TMO      128
#define XB_XCNT(j)  (256  + 64 * (j))
#define XB_XSUB(j)  (1280 + 64 * (j))
#define XB_XGEN(j)  (2304 + 64 * (j))
#define XB_TOP      3328
#define XB_TOPGEN   3392
#define XCD_BAR_WORDS 3456
#define XB_SPIN_CAP (1u << 18)

__device__ __forceinline__ unsigned xb_ld(unsigned* p)              { return __hip_atomic_load(p, __ATOMIC_RELAXED, __HIP_MEMORY_SCOPE_AGENT); }
__device__ __forceinline__ unsigned xb_add(unsigned* p, unsigned v) { return __hip_atomic_fetch_add(p, v, __ATOMIC_RELAXED, __HIP_MEMORY_SCOPE_AGENT); }
__device__ __forceinline__ unsigned xb_xcc_id() { return (unsigned)__builtin_amdgcn_s_getreg((3 << 11) | 20) & 0xFu; }
#define XB_SPIN(cond, bar) do { unsigned _sp = 0; while (cond) { __builtin_amdgcn_s_sleep(1); \
    if ((++_sp & 255u) == 0u) { if (xb_ld(&(bar)[XB_TMO])) break; if (_sp > XB_SPIN_CAP) { atomicAdd(&(bar)[XB_TMO], 1u); break; } } } } while (0)

struct XcdBarrier {
    unsigned* bar; unsigned x;
    volatile LAS unsigned* st;
};

__device__ __forceinline__ XcdBarrier xcd_barrier_post(unsigned* bar, volatile LAS unsigned* st) {
    XcdBarrier b; b.bar = bar; b.x = xb_xcc_id(); b.st = st;
    if (tid_now() == 0) (void)xb_add(&bar[XB_XCNT(b.x)], 1u);
    return b;
}
__device__ __forceinline__ void xcd_barrier_complete(unsigned* bar, unsigned x, unsigned& nloc, unsigned& nx) {
    const unsigned G = gridDim.x * gridDim.y * gridDim.z;
    unsigned sum, cnt, mine, sp = 0u;
    for (;;) {
        sum = 0u; cnt = 0u; mine = 0u;
#pragma unroll
        for (unsigned j = 0; j < 16; ++j) { const unsigned c = xb_ld(&bar[XB_XCNT(j)]); sum += c; cnt += (c > 0u) ? 1u : 0u; mine = (j == x) ? c : mine; }
        if (sum == G) break;
        __builtin_amdgcn_s_sleep(1);
        if ((++sp & 255u) == 0u) { if (xb_ld(&bar[XB_TMO])) break; if (sp > XB_SPIN_CAP) { atomicAdd(&bar[XB_TMO], 1u); break; } }
    }
    nloc = mine > 0u ? mine : 1u; nx = cnt > 0u ? cnt : 1u;
}

__device__ __forceinline__ void xcd_barrier(const XcdBarrier& b) {
    asm volatile("s_waitcnt vmcnt(0)" ::: "memory");
    __syncthreads();
    if (tid_now() == 0) {
        unsigned* bar = b.bar;
        __builtin_amdgcn_s_waitcnt(0);
        unsigned nloc = b.st[0], nx = b.st[1];
        if (nloc == 0u) { xcd_barrier_complete(bar, b.x, nloc, nx); b.st[0] = nloc; b.st[1] = nx; }
        const unsigned old = xb_add(&bar[XB_XSUB(b.x)], 1u);
        const unsigned gen = old / nloc;
        if (old + 1u == (gen + 1u) * nloc) {
            __builtin_amdgcn_fence(__ATOMIC_RELEASE, "agent");
            asm volatile("s_waitcnt vmcnt(0)" ::: "memory");
            const unsigned og = xb_add(&bar[XB_TOP], 1u);
            const unsigned tg = og / nx;
            if (og + 1u == (tg + 1u) * nx) xb_add(&bar[XB_TOPGEN], 1u);
            else XB_SPIN(xb_ld(&bar[XB_TOPGEN]) == tg, bar);
            __builtin_amdgcn_fence(__ATOMIC_ACQUIRE, "agent");
            xb_add(&bar[XB_XGEN(b.x)], 1u);
            asm volatile("s_waitcnt vmcnt(0)" ::: "memory");
        } else {
            XB_SPIN(xb_ld(&bar[XB_XGEN(b.x)]) == gen, bar);
            __builtin_amdgcn_fence(__ATOMIC_ACQUIRE, "agent");
            asm volatile("s_waitcnt vmcnt(0)" ::: "memory");
        }
    }
    __syncthreads();
}

template <bool PERMQK>
__device__ __forceinline__ void p0_transpose_item(const float* W, int K, int N, bf16* WT, LAS float* scr, int item, int lane) {
    const int nblk = N / 32, kb = item / nblk, nb = item % nblk, k0 = 64 * kb, n0 = 32 * nb;
    int nsrc = n0 + (lane & 31);
    if (PERMQK) { if (nsrc >= 4096 && nsrc < 6144 && (nsrc & 63) < 16) { const int p = nsrc & 15; nsrc = (nsrc & ~15) | (p & 3) | ((p & 4) << 1) | ((p & 8) >> 1); } }
    float wv[32];
#pragma unroll
    for (int i = 0; i < 32; ++i) wv[i] = W[(size_t)(k0 + 2 * i + (lane >> 5)) * N + nsrc];
    const float csc = !PERMQK ? 1.0f : (nsrc >= 1024 && nsrc < 2048) ? 0.0625f : (nsrc >= 8192) ? 1.4426950408889634f : 1.0f;
#pragma unroll
    for (int i = 0; i < 32; ++i) scr[(2 * i + (lane >> 5)) * 33 + (lane & 31)] = wv[i] * csc;
    asm volatile("s_waitcnt lgkmcnt(0)" ::: "memory");
    const int c = lane & 7;
#pragma unroll
    for (int j = 0; j < 4; ++j) { const int n = (lane >> 3) + 8 * j; const LAS float* s = scr + (8 * c) * 33 + n;
        u32x4 o; o.x = pk2(s[0 * 33], s[1 * 33]); o.y = pk2(s[2 * 33], s[3 * 33]); o.z = pk2(s[4 * 33], s[5 * 33]); o.w = pk2(s[6 * 33], s[7 * 33]);
        *(u32x4*)(WT + (size_t)(n0 + n) * K + k0 + 8 * c) = o; }
    asm volatile("s_waitcnt lgkmcnt(0)" ::: "memory");
}
__device__ __forceinline__ void p0_mod_item(const float* c, const float* ada_w, float* modp, int item, int lane) {
    const int jg = item % 48, ks = item / 48, j = jg * 64 + lane;
    float w[64];
#pragma unroll
    for (int kk = 0; kk < 64; ++kk) w[kk] = ada_w[(size_t)(ks * 64 + kk) * 3072 + j];
    const int kq = ks * 64 + lane;
    float sc[8], acc[8];
#pragma unroll
    for (int b = 0; b < 8; ++b) { sc[b] = pg8::silu_f(c[b * 1024 + kq]); acc[b] = 0.f; }
#pragma unroll
    for (int kk = 0; kk < 64; ++kk)
#pragma unroll
        for (int b = 0; b < 8; ++b) acc[b] += __uint_as_float((unsigned)__builtin_amdgcn_readlane((int)__float_as_uint(sc[b]), kk)) * w[kk];
    float* o = modp + (size_t)ks * 8 * 3072 + j;
#pragma unroll
    for (int b = 0; b < 8; ++b) o[b * 3072] = acc[b];
}
__device__ __forceinline__ float mod_value(const float* modp, const float* ada_b, int b, int j) {
    float s = 0.f;
#pragma unroll
    for (int ks = 0; ks < 16; ++ks) s += modp[((size_t)ks * 8 + b) * 3072 + j];
    return s + ada_b[j];
}

constexpr int AT_SLOT = 32768, AT_WS = 4 * AT_SLOT, AT_EP = 0, AT_EPP = 132;
__device__ __forceinline__ void glds16(const void* gsrc, unsigned lds_dst) { unsigned keep;
    asm volatile("s_mov_b32 %0, m0\n\ts_mov_b32 m0, %2\n\ts_nop 0\n\tglobal_load_lds_dwordx4 %1, off\n\ts_mov_b32 m0, %0" : "=&s"(keep) : "v"(gsrc), "s"(lds_dst) : "memory"); }
__device__ __forceinline__ void glds16s(const void* sbase, unsigned voff, unsigned lds_dst) { unsigned keep;
    asm volatile("s_mov_b32 %0, m0\n\ts_mov_b32 m0, %3\n\ts_nop 0\n\tglobal_load_lds_dwordx4 %1, %2\n\ts_mov_b32 m0, %0" : "=&s"(keep) : "v"(voff), "s"(sbase), "s"(lds_dst) : "memory"); }
#define AT_WAIT_BAR(N) asm volatile("s_waitcnt vmcnt(" #N ") lgkmcnt(0)\n\ts_barrier" ::: "memory")
#define AT_Z16 (f32x16){0.f, 0.f, 0.f, 0.f, 0.f, 0.f, 0.f, 0.f, 0.f, 0.f, 0.f, 0.f, 0.f, 0.f, 0.f, 0.f}
#define AT_SB() __builtin_amdgcn_sched_barrier(0)
__device__ __forceinline__ float at_max3(float a, float b, float c) { float r; asm("v_max3_f32 %0, %1, %2, %3" : "=v"(r) : "v"(a), "v"(b), "v"(c)); return r; }
__device__ __forceinline__ float at_max2(float a, float b) { float r; asm("v_max_f32_e32 %0, %1, %2" : "=v"(r) : "v"(a), "v"(b)); return r; }
__device__ __forceinline__ float at_add(float a, float b) { float r; asm("v_add_f32_e32 %0, %1, %2" : "=v"(r) : "v"(a), "v"(b)); return r; }
__device__ __forceinline__ float at_rowmax(const f32x16& p0, const f32x16& p1) {
    float a = at_max3(p0[0], p0[1], p1[0]), b = at_max3(p0[2], p0[3], p1[1]); a = at_max3(a, p1[2], p1[3]);
#pragma unroll
    for (int r = 4; r < 16; r += 4) { a = at_max3(a, p0[r], p0[r + 1]); b = at_max3(b, p0[r + 2], p0[r + 3]); a = at_max3(a, p1[r], p1[r + 1]); b = at_max3(b, p1[r + 2], p1[r + 3]); }
    const float m = at_max2(a, b);
    const auto rr = __builtin_amdgcn_permlane32_swap(__float_as_uint(m), __float_as_uint(m), false, false);
    return at_max2(__uint_as_float(rr[0]), __uint_as_float(rr[1]));
}
__device__ __forceinline__ void at_first(const LAS unsigned char* sbK, int koff, const bf16x8 (&qf)[4], bf16x8 (&pa)[4], float& m_run, f32x16& negm) {
    f32x16 p0, p1;
#pragma unroll
    for (int s = 0; s < 4; ++s) {
        const LAS unsigned char* kp = sbK + (koff ^ (s * 32));
        const bf16x8 a0 = *(const LAS bf16x8*)kp, a1 = *(const LAS bf16x8*)(kp + 8192);
        if (s == 0) { p0 = __builtin_amdgcn_mfma_f32_32x32x16_bf16(a0, qf[0], AT_Z16, 0, 0, 0); p1 = __builtin_amdgcn_mfma_f32_32x32x16_bf16(a1, qf[0], AT_Z16, 0, 0, 0); }
        else { p0 = __builtin_amdgcn_mfma_f32_32x32x16_bf16(a0, qf[s], p0, 0, 0, 0); p1 = __builtin_amdgcn_mfma_f32_32x32x16_bf16(a1, qf[s], p1, 0, 0, 0); }
    }
    const float mx = at_rowmax(p0, p1);
    m_run = mx;
#pragma unroll
    for (int r = 0; r < 16; ++r) negm[r] = -mx;
    unsigned pw[16];
#pragma unroll
    for (int j = 0; j < 8; ++j) { pw[j] = cvtpk(__builtin_amdgcn_exp2f(p0[2 * j] - mx), __builtin_amdgcn_exp2f(p0[2 * j + 1] - mx)); pw[8 + j] = cvtpk(__builtin_amdgcn_exp2f(p1[2 * j] - mx), __builtin_amdgcn_exp2f(p1[2 * j + 1] - mx)); }
#pragma unroll
    for (int k = 0; k < 4; ++k) pa[k] = __builtin_bit_cast(bf16x8, (u32x4){pw[4 * k], pw[4 * k + 1], pw[4 * k + 2], pw[4 * k + 3]});
}
template <bool NEXT, bool MASKABLE = false>
__device__ __forceinline__ void at_step(const LAS unsigned char* sbK, const LAS unsigned char* sbV, int koff, int r32, int hi, int vb, int vx, const bf16x8 (&qf)[4], f32x16 (&o)[4], float& l_run,
                                        bf16x8 (&pc)[4], float& m_run, f32x16& negm, LAS float* wsf, bool mask_next = false) {
    f32x16 pS0, pS1;
    bool resc = false; float alpha = 1.0f;
    typedef __bf16 at_bf2 __attribute__((ext_vector_type(2)));
#define AT_RS(k_) do { const u32x4 w_ = __builtin_bit_cast(u32x4, pc[(k_) >> 1]); const at_bf2 one2_ = __builtin_bit_cast(at_bf2, 0x3F803F80u); \
        rs0 = __builtin_amdgcn_fdot2_f32_bf16(__builtin_bit_cast(at_bf2, ((k_) & 1) ? w_.z : w_.x), one2_, rs0, false); \
        rs1 = __builtin_amdgcn_fdot2_f32_bf16(__builtin_bit_cast(at_bf2, ((k_) & 1) ? w_.w : w_.y), one2_, rs1, false); } while (0)
    float rs0 = 0.f, rs1 = 0.f;
    if (NEXT) {
        bf16x8 kf[8];
#define AT_KLD(s_) do { const LAS unsigned char* kp_ = sbK + (koff ^ ((s_) * 32)); kf[2 * (s_)] = *(const LAS bf16x8*)kp_; kf[2 * (s_) + 1] = *(const LAS bf16x8*)(kp_ + 8192); } while (0)
        AT_KLD(0); AT_KLD(1);
        pS0 = __builtin_amdgcn_mfma_f32_32x32x16_bf16(kf[0], qf[0], negm, 0, 0, 0);
        pS1 = __builtin_amdgcn_mfma_f32_32x32x16_bf16(kf[1], qf[0], negm, 0, 0, 0);
        AT_KLD(2);
        pS0 = __builtin_amdgcn_mfma_f32_32x32x16_bf16(kf[2], qf[1], pS0, 0, 0, 0);
        pS1 = __builtin_amdgcn_mfma_f32_32x32x16_bf16(kf[3], qf[1], pS1, 0, 0, 0);
        AT_KLD(3);
        pS0 = __builtin_amdgcn_mfma_f32_32x32x16_bf16(kf[4], qf[2], pS0, 0, 0, 0);
        pS1 = __builtin_amdgcn_mfma_f32_32x32x16_bf16(kf[5], qf[2], pS1, 0, 0, 0);
        pS0 = __builtin_amdgcn_mfma_f32_32x32x16_bf16(kf[6], qf[3], pS0, 0, 0, 0);
        pS1 = __builtin_amdgcn_mfma_f32_32x32x16_bf16(kf[7], qf[3], pS1, 0, 0, 0);
#undef AT_KLD
        if (MASKABLE) { if (mask_next) {
#pragma unroll
            for (int r = 0; r < 16; ++r) { pS0[r] = -1e30f; pS1[r] = -1e30f; } } }
        const float mx = at_rowmax(pS0, pS1);
        if (__any(mx > 8.0f)) {
            const float dl = fmaxf(mx, 0.f); m_run += dl; alpha = __builtin_amdgcn_exp2f(-dl); resc = true;
#pragma unroll
            for (int r = 0; r < 16; ++r) { pS0[r] -= dl; pS1[r] -= dl; negm[r] = -m_run; }
        }
    }
    if (!NEXT) { }
    {
        const LAS unsigned char* vp0 = sbV + 16384 + vb;
#define AT_VF(d_, ks_) cat8(tr_read(vp0 + (ks_) * 4096 + (((d_) * 64) ^ vx)), tr_read(vp0 + (ks_) * 4096 + 2048 + (((d_) * 64) ^ vx)))
        constexpr int PF = 3, RING = PF + 1;
        bf16x8 vfr[RING];
#pragma unroll
        for (int j = 0; j < PF; ++j) vfr[j] = AT_VF(j & 3, j >> 2);
        unsigned pt[4];
#pragma unroll
        for (int j = 0; j < 16; ++j) { const int ks = j >> 2, d = j & 3;
            if (j + PF < 16) vfr[(j + PF) % RING] = AT_VF((j + PF) & 3, (j + PF) >> 2);
            o[d] = __builtin_amdgcn_mfma_f32_32x32x16_bf16(pc[ks], vfr[j % RING], o[d], 0, 0, 0);
            if (NEXT) { if (j < 8) pt[d] = cvtpk(__builtin_amdgcn_exp2f(pS0[2 * j]), __builtin_amdgcn_exp2f(pS0[2 * j + 1]));
                        else pt[d] = cvtpk(__builtin_amdgcn_exp2f(pS1[2 * j - 16]), __builtin_amdgcn_exp2f(pS1[2 * j - 15])); }
            AT_SB();
            if (d == 3) {
                AT_RS(2 * ks); AT_RS(2 * ks + 1);
                if (NEXT) pc[ks] = __builtin_bit_cast(bf16x8, (u32x4){pt[0], pt[1], pt[2], pt[3]});
                AT_SB(); }
        }
#undef AT_VF
    }
#undef AT_RS
    l_run += rs0 + rs1;
    if (resc) {
        if (hi == 0) wsf[r32] = alpha;
        asm volatile("s_waitcnt lgkmcnt(0)" ::: "memory");
        l_run *= alpha;
#pragma unroll
        for (int r = 0; r < 16; ++r) { const float a = wsf[crow(r, hi)];
#pragma unroll
            for (int d = 0; d < 4; ++d) o[d][r] *= a;
            AT_SB(); }
    }
}
__device__ __forceinline__ void attn_unit(LAS unsigned char* lds, const bf16* DQ, const bf16* DK, const bf16* DV, const bf16* DG, bf16* YD, const float* subln_g, float lam, int b, int h, int jq, unsigned* qctr, volatile LAS unsigned* qslot) {
    int tid_ = tid_now(); asm volatile("" : "+v"(tid_));
    const int tid = tid_, lane = tid & 63, wid = __builtin_amdgcn_readfirstlane(tid >> 6), r32 = lane & 31, hi = lane >> 5, rg = wid & 3, map = wid >> 2;
    const size_t rowbase = (size_t)b * SEQ; const int q0 = jq * 128;
    f32x16 o[4];
#pragma unroll
    for (int i = 0; i < 4; ++i) o[i] = (f32x16){0.f, 0.f, 0.f, 0.f, 0.f, 0.f, 0.f, 0.f, 0.f, 0.f, 0.f, 0.f, 0.f, 0.f, 0.f, 0.f};
    float m_run = 0.f;
    const int NT = 2 * jq + 2, my_nt = 2 * jq + 1 + (rg >> 1);
    LAS float* wsf = (LAS float*)(lds + AT_WS) + wid * 64;
    unsigned kof[2], vof[2];
#pragma unroll
    for (int i = 0; i < 2; ++i) { const int key = 8 * wid + 4 * i + (lane >> 4);
        kof[i] = (unsigned)((key * 128 + ((lane & 15) ^ (key & 15)) * 8) * 2); vof[i] = (unsigned)((key * 128 + ((lane & 15) ^ ((key & 3) << 2)) * 8) * 2); }
    const char* kg = (const char*)(DK + ((size_t)(b * 8 + h) * SEQ) * 128); const char* vg = (const char*)(DV + ((size_t)(b * 8 + h) * SEQ) * 128);
    const unsigned lds0 = (unsigned)(uintptr_t)lds;
#define AT_DMA(t, slot) do { const char* sk_ = kg + (size_t)(t) * 16384; const char* sv_ = vg + (size_t)(t) * 16384; const unsigned d_ = (unsigned)__builtin_amdgcn_readfirstlane((int)(lds0 + (unsigned)((slot) * AT_SLOT + wid * 2048))); \
        glds16s(sk_, kof[0], d_); glds16s(sk_, kof[1], d_ + 1024u); glds16s(sv_, vof[0], d_ + 16384u); glds16s(sv_, vof[1], d_ + 16384u + 1024u); } while (0)
    const int koff = r32 * 256 + ((map * 128 + hi * 16) ^ ((r32 & 15) * 16));
    const int vb = (4 * hi + ((lane & 15) >> 2)) * 256 + ((lane >> 4) & 1) * 32 + (lane & 3) * 8, vx = ((lane & 15) >> 2) * 64;
    bf16x8 pa[4]; f32x16 negm; float l_run = 0.f;
    AT_DMA(0, 0); AT_DMA(1, 1); if (NT > 2) AT_DMA(2, 2);
    bf16x8 qf[4];
    { const bf16* qp = DQ + (rowbase + q0 + rg * 32 + r32) * 1024 + h * 128 + map * 64 + hi * 8;
#pragma unroll
      for (int s = 0; s < 4; ++s) qf[s] = *(const bf16x8*)(qp + s * 16); }
    asm volatile("s_waitcnt vmcnt(0)" : "+v"(qf[0]), "+v"(qf[1]), "+v"(qf[2]), "+v"(qf[3]) :: "memory");
    if (NT > 2) AT_WAIT_BAR(8); else AT_WAIT_BAR(4);
    at_first(lds, koff, qf, pa, m_run, negm);
#define AT_TOP(t_) do { if ((t_) + 2 < NT) AT_WAIT_BAR(4); else AT_WAIT_BAR(0);        \
        if ((t_) + 3 < NT) AT_DMA((t_) + 3, ((t_) + 3) & 3); } while (0)
#define AT_SLOTP(t_) (lds + ((t_) & 3) * AT_SLOT)
    for (int t = 0; t + 1 < NT; ++t) {
        AT_TOP(t);
        at_step<true, true>(AT_SLOTP(t + 1), AT_SLOTP(t), koff, r32, hi, vb, vx, qf, o, l_run, pa, m_run, negm, wsf, (t + 2 == NT) && (my_nt != NT));
    }
    AT_TOP(NT - 1);
    at_step<false>(AT_SLOTP(NT), AT_SLOTP(NT - 1), koff, r32, hi, vb, vx, qf, o, l_run, pa, m_run, negm, wsf);
#undef AT_TOP
#undef AT_SLOTP
    int te_ = tid_now(); asm volatile("" : "+v"(te_));
    const int tid2 = te_, lane2 = tid2 & 63, r32b = lane2 & 31, hib = lane2 >> 5;
    { const auto lr = __builtin_amdgcn_permlane32_swap(__float_as_uint(l_run), __float_as_uint(l_run), false, false);
      const float f = (map ? lam : 1.0f) * __builtin_amdgcn_rcpf(__uint_as_float(lr[0]) + __uint_as_float(lr[1]));
      if (hib == 0) wsf[r32b] = f;
      asm volatile("s_waitcnt lgkmcnt(0)" ::: "memory");
#pragma unroll
      for (int r = 0; r < 16; ++r) { const float a = wsf[crow(r, hib)];
#pragma unroll
          for (int d = 0; d < 4; ++d) o[d][r] *= a; } }
    LAS float* ep = (LAS float*)(lds + AT_EP);
    const int rowE = tid2 >> 2, segE = tid2 & 3;
    const size_t offE = (rowbase + q0 + rowE) * 1024 + h * 128 + segE * 32;
    u32x4 gE[4];
#pragma unroll
    for (int i = 0; i < 4; ++i) gE[i] = *(const u32x4*)(DG + offE + 8 * i);
    f32x4 sgE[8];
#pragma unroll
    for (int i = 0; i < 8; ++i) sgE[i] = *(const f32x4*)(subln_g + segE * 32 + 4 * i);
    unsigned qnext = 1u; { const unsigned z_ = 0u; if (tid2 == 0) asm volatile("global_atomic_add %0, %1, %0, %2 sc0" : "+v"(qnext) : "v"(z_), "s"(qctr) : "memory"); }
#define AT_EBAR() asm volatile("s_waitcnt lgkmcnt(0)\n\ts_barrier" ::: "memory")
    AT_EBAR();
    if (map == 1) {
#pragma unroll
        for (int r = 0; r < 16; ++r)
#pragma unroll
            for (int d = 0; d < 4; ++d) ep[(rg * 32 + crow(r, hib)) * AT_EPP + d * 32 + r32b] = o[d][r];
    }
    AT_EBAR();
    if (map == 0) {
#pragma unroll
        for (int r = 0; r < 16; ++r)
#pragma unroll
            for (int d = 0; d < 4; ++d) { LAS float* e = ep + (rg * 32 + crow(r, hib)) * AT_EPP + d * 32 + r32b; *e = o[d][r] - *e; }
    }
    AT_EBAR();
#undef AT_EBAR
    { const int row = rowE, seg = segE;
      const LAS float* e = ep + row * AT_EPP + seg * 32;
      f32x4 v[8]; float ss = 0.f;
#pragma unroll
      for (int i = 0; i < 8; ++i) { v[i] = *(const LAS f32x4*)(e + 4 * i); ss += (v[i][0] * v[i][0] + v[i][1] * v[i][1]) + (v[i][2] * v[i][2] + v[i][3] * v[i][3]); }
      ss += __shfl_xor(ss, 1); ss += __shfl_xor(ss, 2);
      const float rstd = 0.8f * __builtin_amdgcn_rsqf(ss * (1.0f / 128.0f) + 1e-6f);
      const size_t off = offE;
#pragma unroll
      for (int i = 0; i < 4; ++i) {
          const u32x4 g = gE[i];
          const f32x4 s0 = sgE[2 * i], s1 = sgE[2 * i + 1];
          const f32x4 a = v[2 * i], c = v[2 * i + 1]; u32x4 w;
          w.x = cvtpk(a[0] * rstd * s0[0] * bflo(g.x), a[1] * rstd * s0[1] * bfhi(g.x)); w.y = cvtpk(a[2] * rstd * s0[2] * bflo(g.y), a[3] * rstd * s0[3] * bfhi(g.y));
          w.z = cvtpk(c[0] * rstd * s1[0] * bflo(g.z), c[1] * rstd * s1[1] * bfhi(g.z)); w.w = cvtpk(c[2] * rstd * s1[2] * bflo(g.w), c[3] * rstd * s1[3] * bfhi(g.w));
          *(u32x4*)(YD + off + 8 * i) = w; } }
    asm volatile("s_waitcnt vmcnt(4)" : "+v"(qnext) :: "memory");
    if (tid2 == 0) qslot[0] = qnext;
    asm volatile("s_waitcnt lgkmcnt(0)\n\ts_barrier" ::: "memory");
#undef AT_DMA
}

constexpr int RT_Q = 0, RT_K0 = 32768, RT_V = 98304, RT_S = 131072, RT_SP = 144, RT_ST = 140288, RT_NG = 144384;
__device__ __forceinline__ int rt_swz(int row) { return ((row & 3) << 2) | ((row >> 2) & 3); }
__device__ __forceinline__ void ret_unit(LAS unsigned char* lds, const bf16* RQ, const bf16* RK, const bf16* RV, const bf16* RG, bf16* YR, const float* ret_g, int b, int h) {
    int tid_ = tid_now(); asm volatile("" : "+v"(tid_));
    const int tid = tid_, lane = tid & 63, wid = __builtin_amdgcn_readfirstlane(tid >> 6);
    const float lg2 = __builtin_log2f(1.0f - __builtin_exp2f(-5.0f - (4.0f / 3.0f) * (float)h));
    if (tid < 256) ((LAS float*)(lds + RT_NG))[tid] = ret_g[h * 256 + tid];
    f32x16 st[8];
#pragma unroll
    for (int T = 0; T < 8; ++T) st[T] = (f32x16){0.f, 0.f, 0.f, 0.f, 0.f, 0.f, 0.f, 0.f, 0.f, 0.f, 0.f, 0.f, 0.f, 0.f, 0.f, 0.f};
    const unsigned lds0 = (unsigned)(uintptr_t)lds;
    unsigned qko[4];
#pragma unroll
    for (int i = 0; i < 4; ++i) { const int row = 8 * wid + 2 * i + (lane >> 5), c = (lane & 31) ^ rt_swz(row); qko[i] = (unsigned)((row * 1024 + h * 256 + c * 8) * 2); }
    const unsigned vo = (unsigned)(((lane >> 2) * 1024 + h * 256 + wid * 32 + (lane & 3) * 8) * 2);
    const char* qg = (const char*)(RQ + (size_t)b * SEQ * 1024); const char* kg = (const char*)(RK + (size_t)b * SEQ * 1024); const char* vg = (const char*)(RV + (size_t)b * SEQ * 1024);
#define RT_DMA_QK(gbase, n_, ldsoff) do { const char* sb_ = (gbase) + (size_t)(n_) * (64 * 1024 * 2); const unsigned d_ = (unsigned)__builtin_amdgcn_readfirstlane((int)(lds0 + (unsigned)((ldsoff) + wid * 4096))); \
        glds16s(sb_, qko[0], d_); glds16s(sb_, qko[1], d_ + 1024u); glds16s(sb_, qko[2], d_ + 2048u); glds16s(sb_, qko[3], d_ + 3072u); } while (0)
#define RT_DMA_V(n_) do { const char* sb_ = vg + (size_t)(n_) * (64 * 1024 * 2); const unsigned d_ = (unsigned)__builtin_amdgcn_readfirstlane((int)(lds0 + (unsigned)(RT_V + wid * 4096))); \
        glds16s(sb_, vo, d_); glds16s(sb_ + 16 * 1024 * 2, vo, d_ + 1024u); glds16s(sb_ + 32 * 1024 * 2, vo, d_ + 2048u); glds16s(sb_ + 48 * 1024 * 2, vo, d_ + 3072u); } while (0)
    RT_DMA_QK(qg, 0, RT_Q); RT_DMA_QK(kg, 0, RT_K0); RT_DMA_QK(kg, 1, RT_K0 + 32768); RT_DMA_V(0);
    asm volatile("s_waitcnt vmcnt(0) lgkmcnt(0)\n\ts_barrier" ::: "memory");
    for (int n = 0; n < 64; ++n) {
        const size_t tok0 = (size_t)b * SEQ + (size_t)n * CHUNK;
        float lg = lg2; asm volatile("" : "+v"(lg));
        const float ginv = __builtin_amdgcn_exp2f(-lg);
        const int jn = n & 3;
        const int kbuf = RT_K0 + (n & 1) * 32768;
        int ln = lane; asm volatile("" : "+v"(ln));
        const int r32 = ln & 31, hi = ln >> 5;
        const LAS unsigned char* vw = lds + RT_V + wid * 4096;
        const int vaddr = (8 * hi + ((ln & 15) >> 2)) * 64 + ((ln >> 4) & 1) * 32 + (ln & 3) * 8;
        bf16x8 vf[4];
#pragma unroll
        for (int s = 0; s < 4; ++s) vf[s] = cat8(tr_read(vw + s * 1024 + vaddr), tr_read(vw + s * 1024 + vaddr + 256));
        asm volatile("s_waitcnt lgkmcnt(0)" : "+v"(vf[0]), "+v"(vf[1]), "+v"(vf[2]), "+v"(vf[3]) :: "memory");
        if (n + 1 < 64) RT_DMA_V(n + 1);
        { const int ct = wid >> 1, mt0 = 2 * (wid & 1);
          const int l15 = ln & 15, kq = ln >> 4, s1_x = (l15 & 3) * 64, s1_lo = (kq ^ (l15 >> 2)) * 16;
          f32x4 sa = (f32x4){0.f, 0.f, 0.f, 0.f}, sb = sa;
          const LAS unsigned char* qb = lds + RT_Q + (16 * ct + l15) * 512 + s1_lo;
          const LAS unsigned char* kb = lds + kbuf + (16 * mt0 + l15) * 512 + s1_lo;
#pragma unroll
          for (int s = 0; s < 8; ++s) {
              const int xo = (s * 64) ^ s1_x;
              const bf16x8 bq = *(const LAS bf16x8*)(qb + xo), ka = *(const LAS bf16x8*)(kb + xo), kc = *(const LAS bf16x8*)(kb + 16 * 512 + xo);
              sa = __builtin_amdgcn_mfma_f32_16x16x32_bf16(ka, bq, sa, 0, 0, 0);
              sb = __builtin_amdgcn_mfma_f32_16x16x32_bf16(kc, bq, sb, 0, 0, 0);
          }
          const int cabs = 16 * ct + l15;
#pragma unroll
          for (int tt = 0; tt < 2; ++tt) { const f32x4 sv = tt ? sb : sa; const int m0 = 16 * (mt0 + tt) + 4 * kq; float dv[4];
#pragma unroll
              for (int r = 0; r < 4; ++r) { const int dl = cabs - (m0 + r); dv[r] = sv[r] * __builtin_amdgcn_exp2f(lg * (float)(dl < 0 ? -dl : dl)); }
              *(LAS u32x2*)(lds + RT_S + cabs * RT_SP + m0 * 2) = (u32x2){cvtpk(dv[0], dv[1]), cvtpk(dv[2], dv[3])}; } }
        if (jn == 0) { const float g4 = __builtin_amdgcn_exp2f(256.0f * lg);
#pragma unroll
            for (int T = 0; T < 8; ++T)
#pragma unroll
                for (int r = 0; r < 16; ++r) st[T][r] *= g4; }
        f32x16 ao[2];
        ao[0] = (f32x16){0.f, 0.f, 0.f, 0.f, 0.f, 0.f, 0.f, 0.f, 0.f, 0.f, 0.f, 0.f, 0.f, 0.f, 0.f, 0.f}; ao[1] = ao[0];
        {
          int l3 = ln; asm volatile("" : "+v"(l3));
          const int q3_x = (l3 & 3) * 64, q3_y0 = ((l3 >> 5) ^ ((l3 >> 2) & 3)) * 16, q3_y1 = ((2 + (l3 >> 5)) ^ ((l3 >> 2) & 3)) * 16;
          const LAS unsigned char* q3 = lds + RT_Q + (l3 & 31) * 512;
#define RT_Q3(T_, s_, ct_) (*(const LAS bf16x8*)(q3 + (ct_) * 32 * 512 + ((s_) ? q3_y1 : q3_y0) + (((T_) * 64) ^ q3_x)))
          bf16x8 qa[2][2];
          qa[0][0] = RT_Q3(0, 0, 0); qa[0][1] = RT_Q3(0, 0, 1);
#pragma unroll
          for (int it = 0; it < 16; ++it) { const int T = it >> 1, s = it & 1, cur = it & 1, nx = cur ^ 1;
              if (it + 1 < 16) { qa[nx][0] = RT_Q3((it + 1) >> 1, (it + 1) & 1, 0); qa[nx][1] = RT_Q3((it + 1) >> 1, (it + 1) & 1, 1); }
              u32x4 w; const int bs = 8 * s;
              w.x = cvtpk(st[T][bs], st[T][bs + 1]); w.y = cvtpk(st[T][bs + 2], st[T][bs + 3]); w.z = cvtpk(st[T][bs + 4], st[T][bs + 5]); w.w = cvtpk(st[T][bs + 6], st[T][bs + 7]);
              const bf16x8 sA = __builtin_bit_cast(bf16x8, w);
              ao[0] = __builtin_amdgcn_mfma_f32_32x32x16_bf16(sA, qa[cur][0], ao[0], 0, 0, 0);
              ao[1] = __builtin_amdgcn_mfma_f32_32x32x16_bf16(sA, qa[cur][1], ao[1], 0, 0, 0);
              __builtin_amdgcn_sched_barrier(0); }
#undef RT_Q3
        }
        { const float xi0 = __builtin_amdgcn_exp2f(lg * (float)(r32 + 1 + 64 * jn)), xi1 = __builtin_amdgcn_exp2f(lg * (float)(r32 + 33 + 64 * jn));
#pragma unroll
          for (int r = 0; r < 16; ++r) { ao[0][r] *= xi0; ao[1][r] *= xi1; } }
        u32x2 gt[2][4];
#pragma unroll
        for (int ct = 0; ct < 2; ++ct)
#pragma unroll
            for (int g = 0; g < 4; ++g) gt[ct][g] = *(const u32x2*)(RG + (tok0 + 32 * ct + r32) * 1024 + h * 256 + wid * 32 + 4 * hi + 8 * g);
        asm volatile("s_waitcnt lgkmcnt(0)\n\ts_barrier" ::: "memory");
        if (n + 1 < 64) RT_DMA_QK(qg, n + 1, RT_Q);
#pragma unroll
        for (int ct = 0; ct < 2; ++ct)
#pragma unroll
            for (int s = 0; s < 4; ++s) {
                const bf16x8 sB = *(const LAS bf16x8*)(lds + RT_S + (32 * ct + r32) * RT_SP + (16 * s + 8 * hi) * 2);
                ao[ct] = __builtin_amdgcn_mfma_f32_32x32x16_bf16(vf[s], sB, ao[ct], 0, 0, 0);
            }
        LAS float* stp = (LAS float*)(lds + RT_ST);
#pragma unroll
        for (int ct = 0; ct < 2; ++ct) { float s1 = 0.f, s2 = 0.f;
#pragma unroll
            for (int r = 0; r < 16; ++r) { s1 += ao[ct][r]; s2 += ao[ct][r] * ao[ct][r]; }
            s1 += __shfl_xor(s1, 32); s2 += __shfl_xor(s2, 32);
            if (hi == 0) { stp[(wid * 64 + 32 * ct + r32) * 2] = s1; stp[(wid * 64 + 32 * ct + r32) * 2 + 1] = s2; } }
#pragma unroll
        for (int s = 0; s < 4; ++s) { u32x4 w = __builtin_bit_cast(u32x4, vf[s]);
            const float z0 = __builtin_amdgcn_exp2f(lg * (float)(63 - 16 * s - 8 * hi - 64 * (jn + 1))), z1 = z0 * ginv, z2 = z1 * ginv, z3 = z2 * ginv, z4 = z3 * ginv, z5 = z4 * ginv, z6 = z5 * ginv, z7 = z6 * ginv;
            w.x = cvtpk(bflo(w.x) * z0, bfhi(w.x) * z1); w.y = cvtpk(bflo(w.y) * z2, bfhi(w.y) * z3); w.z = cvtpk(bflo(w.z) * z4, bfhi(w.z) * z5); w.w = cvtpk(bflo(w.w) * z6, bfhi(w.w) * z7);
            vf[s] = __builtin_bit_cast(bf16x8, w); }
        {
          int l4 = ln; asm volatile("" : "+v"(l4));
          const int h4 = l4 >> 5, sw = ((l4 & 1) << 1) | ((l4 >> 1) & 1), cw = 2 * ((l4 >> 4) & 1) + (sw >> 1);
          const int k4_x = ((l4 & 15) >> 2) * 64, k4_z0 = (cw ^ ((2 * h4) & 3)) * 16 + (sw & 1) * 8, k4_z1 = (cw ^ ((2 * h4 + 1) & 3)) * 16 + (sw & 1) * 8;
          const LAS unsigned char* k4 = lds + kbuf + (8 * h4 + ((l4 & 15) >> 2)) * 512;
#define RT_K4(T_, s_) cat8(tr_read(k4 + (s_) * 8192 + k4_z0 + (((T_) * 64) ^ k4_x)), tr_read(k4 + (s_) * 8192 + 2048 + k4_z1 + (((T_) * 64) ^ k4_x)))
          bf16x8 ka[2][2];
          ka[0][0] = RT_K4(0, 0); ka[0][1] = RT_K4(0, 1);
#pragma unroll
          for (int it = 0; it < 16; ++it) { const int T = it >> 1, sp = it & 1, cur = it & 1, nx = cur ^ 1;
              if (it + 1 < 16) { ka[nx][0] = RT_K4((it + 1) >> 1, 2 * ((it + 1) & 1)); ka[nx][1] = RT_K4((it + 1) >> 1, 2 * ((it + 1) & 1) + 1); }
              st[T] = __builtin_amdgcn_mfma_f32_32x32x16_bf16(ka[cur][0], vf[2 * sp], st[T], 0, 0, 0);
              st[T] = __builtin_amdgcn_mfma_f32_32x32x16_bf16(ka[cur][1], vf[2 * sp + 1], st[T], 0, 0, 0);
              __builtin_amdgcn_sched_barrier(0); }
#undef RT_K4
        }
        asm volatile("s_waitcnt vmcnt(0) lgkmcnt(0)\n\ts_barrier" ::: "memory");
        if (n + 2 < 64) RT_DMA_QK(kg, n + 2, kbuf);
#pragma unroll
        for (int ct = 0; ct < 2; ++ct) { float s1 = 0.f, s2 = 0.f;
#pragma unroll
            for (int w8 = 0; w8 < 8; ++w8) { s1 += stp[(w8 * 64 + 32 * ct + r32) * 2]; s2 += stp[(w8 * 64 + 32 * ct + r32) * 2 + 1]; }
            const float mean = s1 * (1.0f / 256.0f), var = fmaxf(s2 * (1.0f / 256.0f) - mean * mean, 0.f), rstd = __builtin_amdgcn_rsqf(var + 1e-5f);
            const size_t tokoff = (tok0 + 32 * ct + r32) * 1024 + h * 256 + wid * 32 + 4 * hi;
#pragma unroll
            for (int g = 0; g < 4; ++g) {
                const u32x2 gv = gt[ct][g];
                const f32x4 ng = *(const LAS f32x4*)(lds + RT_NG + (wid * 32 + 8 * g + 4 * hi) * 4);
                const float y0 = (ao[ct][4 * g] - mean) * rstd * ng[0] * bflo(gv.x), y1 = (ao[ct][4 * g + 1] - mean) * rstd * ng[1] * bfhi(gv.x);
                const float y2 = (ao[ct][4 * g + 2] - mean) * rstd * ng[2] * bflo(gv.y), y3 = (ao[ct][4 * g + 3] - mean) * rstd * ng[3] * bfhi(gv.y);
                *(u32x2*)(YR + tokoff + 8 * g) = (u32x2){cvtpk(y0, y1), cvtpk(y2, y3)}; } }
    }
    asm volatile("s_waitcnt vmcnt(0) lgkmcnt(0)" ::: "memory");
    __syncthreads();
#undef RT_DMA_QK
#undef RT_DMA_V
}

__global__ void __launch_bounds__(NTHREADS, 2) fwd_megakernel(Args a) {
    extern __shared__ __attribute__((aligned(16))) unsigned char lds_raw[];
    LAS unsigned char* lds = (LAS unsigned char*)lds_raw;
    { const int t0 = threadIdx.x; if ((t0 & 63) == 0) ((volatile LAS unsigned char*)lds)[TIDTAB_OFF + hw_wave_slot()] = (unsigned char)(t0 >> 6); }
    __syncthreads();
    int tidk_ = tid_now(); asm volatile("" : "+v"(tidk_));
    const int tid = tidk_, lane = tid & 63, wave = __builtin_amdgcn_readfirstlane(tid >> 6);
    const int G = gridDim.x, blk = blockIdx.x;
    unsigned char* ws = a.ws;
    unsigned* ctl = (unsigned*)(ws + WS_CTL);
    float* modp = (float*)(ws + WS_MODP);
    bf16 *Win_t = (bf16*)(ws + WS_WIN), *Wr_t = (bf16*)(ws + WS_WR), *Wd_t = (bf16*)(ws + WS_WD), *Wo_t = (bf16*)(ws + WS_WO);
    float* ssq = (float*)(ws + WS_SSQ);
    bf16 *Hb = (bf16*)(ws + WS_H), *RQ = (bf16*)(ws + WS_RQ), *RK = (bf16*)(ws + WS_RK), *RV = (bf16*)(ws + WS_RV), *RG = (bf16*)(ws + WS_RG), *DQ = (bf16*)(ws + WS_DQ), *DK = (bf16*)(ws + WS_DK);
    bf16 *DV = (bf16*)a.out, *DG = (bf16*)a.out + (size_t)M * 1024;
    volatile LAS unsigned* MISC = (volatile LAS unsigned*)(lds + LDS_BYTES - 192);
    if (tid < 32) MISC[tid] = 0u;
    __syncthreads();
    const unsigned bar_x = (unsigned)__builtin_amdgcn_readfirstlane((int)xcd_barrier_post(ctl + CW_BAR, MISC).x);
#define GRID_BAR() do { XcdBarrier b_; { unsigned* p_ = (unsigned*)(a.ws + WS_CTL) + CW_BAR; asm volatile("" : "+s"(p_)); b_.bar = p_; } b_.x = bar_x; b_.st = (volatile LAS unsigned*)(lds + LDS_BYTES - 192); xcd_barrier(b_); } while (0)

    for (int rep_ = 0; rep_ < REP_P0; ++rep_)
    {
        LAS float* scr = (LAS float*)(lds + wave * 16384);
        constexpr int I_IN = (D / 64) * (NPROJ / 32), I_SQ = (D / 64) * (D / 32), I_MOD = 48 * 16;
        constexpr int NITEMS = I_IN + 3 * I_SQ;
        for (int it = wave * G + blk; it < I_MOD; it += NWAVES * G) p0_mod_item(a.c, a.ada_w, modp, it, lane);
        const int t_lo = (int)((long)NITEMS * blk / G), t_hi = (int)((long)NITEMS * (blk + 1) / G);
        for (;;) {
            unsigned idx = 0; if (lane == 0) idx = __hip_atomic_fetch_add((LAS unsigned*)(lds + LDS_BYTES - 192 + 80), 1u, __ATOMIC_RELAXED, __HIP_MEMORY_SCOPE_WORKGROUP);
            const int it = t_lo + __builtin_amdgcn_readfirstlane((int)idx);
            if (it >= t_hi) break;
            int r = it;
            if (r < I_IN) { p0_transpose_item<true>(a.w_in, D, NPROJ, Win_t, scr, r, lane); continue; } r -= I_IN;
            if (r < I_SQ) { p0_transpose_item<false>(a.w_br, D, D, Wr_t, scr, r, lane); continue; } r -= I_SQ;
            if (r < I_SQ) { p0_transpose_item<false>(a.w_bd, D, D, Wd_t, scr, r, lane); continue; } r -= I_SQ;
            p0_transpose_item<false>(a.w_out, D, D, Wo_t, scr, r, lane);
        }
    }
    GRID_BAR();

    for (int rep_ = 0; rep_ < REP_P1; ++rep_)
    {
        int tid = tid_now(); asm volatile("" : "+v"(tid)); const int lane = tid & 63, wave = __builtin_amdgcn_readfirstlane(tid >> 6);
        int blko = blockIdx.x; asm volatile("" : "+s"(blko));
        const int rows_per = M / G, row_lo = blko * rows_per, b = row_lo / SEQ;
        LAS float* gs = (LAS float*)(lds + 131072); LAS float* sh = gs + 1024;
        __syncthreads();
        for (int k = tid; k < 1024; k += NTHREADS) {
            gs[k] = a.pre_g[k] * (1.0f + mod_value(modp, a.ada_b, b, 1024 + k));
            sh[k] = mod_value(modp, a.ada_b, b, k);
        }
        __syncthreads();
        f32x4 vnx[2][4];
        { const f32x4* xr0 = (const f32x4*)(a.x + (size_t)(row_lo + wave) * D) + lane; const f32x4* xr1 = xr0 + (size_t)NWAVES * (D / 4);
#pragma unroll
          for (int j = 0; j < 4; ++j) { vnx[0][j] = __builtin_nontemporal_load(xr0 + 64 * j); vnx[1][j] = __builtin_nontemporal_load(xr1 + 64 * j); } }
        for (int r = wave; r < rows_per; r += 2 * NWAVES) {
            const int m0 = row_lo + r, m1 = m0 + NWAVES;
            f32x4 v[2][4]; float s0 = 0.f, s1 = 0.f;
#pragma unroll
            for (int j = 0; j < 4; ++j) { v[0][j] = vnx[0][j]; v[1][j] = vnx[1][j]; }
            if (r + 2 * NWAVES < rows_per) { const f32x4* xr0 = (const f32x4*)(a.x + (size_t)(m0 + 2 * NWAVES) * D) + lane; const f32x4* xr1 = xr0 + (size_t)NWAVES * (D / 4);
#pragma unroll
                for (int j = 0; j < 4; ++j) { vnx[0][j] = __builtin_nontemporal_load(xr0 + 64 * j); vnx[1][j] = __builtin_nontemporal_load(xr1 + 64 * j); } }
#pragma unroll
            for (int j = 0; j < 4; ++j) { s0 += (v[0][j][0] * v[0][j][0] + v[0][j][1] * v[0][j][1]) + (v[0][j][2] * v[0][j][2] + v[0][j][3] * v[0][j][3]);
                                          s1 += (v[1][j][0] * v[1][j][0] + v[1][j][1] * v[1][j][1]) + (v[1][j][2] * v[1][j][2] + v[1][j][3] * v[1][j][3]); }
            const float rstd0 = __builtin_amdgcn_rsqf(wave_sum(s0) * (1.0f / D) + 1e-6f), rstd1 = __builtin_amdgcn_rsqf(wave_sum(s1) * (1.0f / D) + 1e-6f);
            u32x2 h0[4], h1[4];
#pragma unroll
            for (int j = 0; j < 4; ++j) { const int k = 4 * lane + 256 * j;
                const f32x4 g4 = *(const LAS f32x4*)(gs + k), s4 = *(const LAS f32x4*)(sh + k);
                h0[j] = (u32x2){pk2(v[0][j][0] * rstd0 * g4[0] + s4[0], v[0][j][1] * rstd0 * g4[1] + s4[1]), pk2(v[0][j][2] * rstd0 * g4[2] + s4[2], v[0][j][3] * rstd0 * g4[3] + s4[3])};
                h1[j] = (u32x2){pk2(v[1][j][0] * rstd1 * g4[0] + s4[0], v[1][j][1] * rstd1 * g4[1] + s4[1]), pk2(v[1][j][2] * rstd1 * g4[2] + s4[2], v[1][j][3] * rstd1 * g4[3] + s4[3])}; }
            const bool odd = lane & 1;
#pragma unroll
            for (int jp = 0; jp < 2; ++jp) {
#pragma unroll
                for (int rr = 0; rr < 2; ++rr) { const u32x2 A = rr ? h1[2 * jp] : h0[2 * jp], B = rr ? h1[2 * jp + 1] : h0[2 * jp + 1];
                    const u32x2 snd = odd ? A : B;
                    const u32x2 rcv = (u32x2){(unsigned)__shfl_xor((int)snd.x, 1), (unsigned)__shfl_xor((int)snd.y, 1)};
                    const u32x4 w = odd ? (u32x4){rcv.x, rcv.y, B.x, B.y} : (u32x4){A.x, A.y, rcv.x, rcv.y};
                    bf16* rowp = Hb + (size_t)(rr ? m1 : m0) * D + 256 * (2 * jp + (odd ? 1 : 0)) + 8 * (lane >> 1);
                    *(u32x4*)rowp = w; }
            }
        }
    }
    GRID_BAR();

    for (int rep_ = 0; rep_ < REP_P2; ++rep_)
    {
        pg8::Gemm g{Hb, Win_t, M, NMIX, D}; pg8::StaticOrder S; S.init(M, NMIX, G, blk);
        pg8::EpiInProj E{RQ, RK, RV, RG, DQ, DK, DV, DG, a.pos};
        pg8::gemm_phase<pg8::EpiInProj, pg8::StaticOrder, true, true>(lds, g, S, E);
    }
    GRID_BAR();

    {
#ifndef SKIP_RET
        if (blk < BATCH * 4) ret_unit(lds, RQ, RK, RV, RG, RQ, a.ret_g, blk >> 2, blk & 3);
#endif
        int tid = tid_now(); asm volatile("" : "+v"(tid)); const int lane = tid & 63;
        float d1 = a.lq1[lane] * a.lk1[lane], d2 = a.lq2[lane] * a.lk2[lane];
        d1 = wave_sum(d1); d2 = wave_sum(d2);
        const float lam = __uint_as_float((unsigned)__builtin_amdgcn_readfirstlane((int)__float_as_uint(__expf(d1) - __expf(d2) + 0.2f)));
        volatile LAS unsigned* qslot = MISC + 16;
        __syncthreads();
        if (tid == 0) qslot[0] = atomicAdd(ctl, 1u);
        __syncthreads();
        for (;;) {
            const unsigned idx = qslot[0];
            if (idx >= 2048u) break;
            const int jq = 31 - (int)(idx >> 6), bh = (int)(idx & 63);
            attn_unit(lds, DQ, DK, DV, DG, DQ, a.subln_g, lam, bh >> 3, bh & 7, jq, ctl, qslot);
        }
    }
    GRID_BAR();

    for (int rep_ = 0; rep_ < REP_P4; ++rep_)
    {
        pg8::Gemm g{Hb, Win_t + (size_t)NMIX * D, M, NGATE, D}; pg8::StaticOrder S; S.init(M, NGATE, G, blk);
        pg8::EpiSigmoid E{RK, RV};
        pg8::gemm_phase<pg8::EpiSigmoid, pg8::StaticOrder, true, true>(lds, g, S, E);
    }
    static_assert(NGATE == 2 * D, "gate tiles (pm, pn) and (pm, pn + 4) must land on the workgroup that runs branch tile (pm, pn)");

    for (int rep_ = 0; rep_ < REP_P5; ++rep_)
    {
        pg8::StaticOrder S; S.init(M, D, G, blk);
        { pg8::Gemm g{RQ, Wr_t, M, D, D}; pg8::EpiGate<false> E{RK, nullptr, DK}; pg8::gemm_phase<pg8::EpiGate<false>, pg8::StaticOrder, true, true>(lds, g, S, E); }
        { pg8::Gemm g{DQ, Wd_t, M, D, D}; pg8::EpiGate<true> E{RV, DK, DK}; pg8::gemm_phase<pg8::EpiGate<true>, pg8::StaticOrder, true, true>(lds, g, S, E); }
    }
    GRID_BAR();

    for (int rep_ = 0; rep_ < REP_P6; ++rep_)
    {
        pg8::Gemm g{DK, Wo_t, M, D, D}; pg8::StaticOrder S; S.init(M, D, G, blk);
        pg8::EpiOutSsq E{Hb, ssq};
        pg8::gemm_phase<pg8::EpiOutSsq, pg8::StaticOrder, true, true>(lds, g, S, E);
    }
    GRID_BAR();

    for (int rep_ = 0; rep_ < REP_P7; ++rep_)
    {
        int tid = tid_now(); asm volatile("" : "+v"(tid)); const int lane = tid & 63, wave = __builtin_amdgcn_readfirstlane(tid >> 6);
        int blko = blockIdx.x; asm volatile("" : "+s"(blko));
        const int rows_per = M / G, row_lo = blko * rows_per, b = row_lo / SEQ;
        LAS float* gp = (LAS float*)lds;
        __syncthreads();
        for (int k = tid; k < 1024; k += NTHREADS) gp[k] = a.post_g[k] * mod_value(modp, a.ada_b, b, 2048 + k);
        __syncthreads();
        f32x4 xn[2][4]; u32x2 on[2][4]; float sn0, sn1;
#define P7_FETCH(m0_) do { const int m0f = (m0_), m1f = m0f + NWAVES; \
            const f32x4* xr0 = (const f32x4*)(a.x + (size_t)m0f * D) + lane; const f32x4* xr1 = (const f32x4*)(a.x + (size_t)m1f * D) + lane; \
            const u32x2* ob0 = (const u32x2*)(Hb + (size_t)m0f * D) + lane; const u32x2* ob1 = (const u32x2*)(Hb + (size_t)m1f * D) + lane; \
            _Pragma("unroll") for (int j = 0; j < 4; ++j) { xn[0][j] = __builtin_nontemporal_load(xr0 + 64 * j); on[0][j] = __builtin_nontemporal_load(ob0 + 64 * j); \
                                                            xn[1][j] = __builtin_nontemporal_load(xr1 + 64 * j); on[1][j] = __builtin_nontemporal_load(ob1 + 64 * j); } \
            sn0 = (lane < 16) ? ssq[(size_t)m0f * 16 + lane] : 0.f; sn1 = (lane < 16) ? ssq[(size_t)m1f * 16 + lane] : 0.f; } while (0)
        P7_FETCH(row_lo + wave);
        for (int r = wave; r < rows_per; r += 2 * NWAVES) {
            const int m0 = row_lo + r, m1 = m0 + NWAVES;
            f32x4 xv[2][4]; u32x2 ov[2][4];
#pragma unroll
            for (int j = 0; j < 4; ++j) { xv[0][j] = xn[0][j]; xv[1][j] = xn[1][j]; ov[0][j] = on[0][j]; ov[1][j] = on[1][j]; }
            const float s0 = sn0, s1 = sn1;
            if (r + 2 * NWAVES < rows_per) P7_FETCH(m0 + 2 * NWAVES);
            const float rstd0 = __builtin_amdgcn_rsqf(wave_sum(s0) * (1.0f / D) + 1e-6f), rstd1 = __builtin_amdgcn_rsqf(wave_sum(s1) * (1.0f / D) + 1e-6f);
            f32x4* yo0 = (f32x4*)(a.out + (size_t)m0 * D) + lane; f32x4* yo1 = (f32x4*)(a.out + (size_t)m1 * D) + lane;
#pragma unroll
            for (int j = 0; j < 4; ++j) { const int k = 4 * lane + 256 * j; const f32x4 g4 = *(const LAS f32x4*)(gp + k);
                f32x4 y0, y1;
                y0[0] = xv[0][j][0] + bflo(ov[0][j].x) * rstd0 * g4[0]; y0[1] = xv[0][j][1] + bfhi(ov[0][j].x) * rstd0 * g4[1]; y0[2] = xv[0][j][2] + bflo(ov[0][j].y) * rstd0 * g4[2]; y0[3] = xv[0][j][3] + bfhi(ov[0][j].y) * rstd0 * g4[3];
                y1[0] = xv[1][j][0] + bflo(ov[1][j].x) * rstd1 * g4[0]; y1[1] = xv[1][j][1] + bfhi(ov[1][j].x) * rstd1 * g4[1]; y1[2] = xv[1][j][2] + bflo(ov[1][j].y) * rstd1 * g4[2]; y1[3] = xv[1][j][3] + bfhi(ov[1][j].y) * rstd1 * g4[3];
                __builtin_nontemporal_store(y0, yo0 + 64 * j); __builtin_nontemporal_store(y1, yo1 + 64 * j); }
        }
    }
}

extern "C" void kernel_launch(void* const* d_in, const int* in_sizes, int n_in, void* d_out, int out_size, void* d_ws, size_t ws_size, hipStream_t stream) {
    static int grid = 0;
    if (grid == 0) {
        if (n_in != 17 || in_sizes[0] != M * D || out_size != M * D || ws_size < WS_END) { fprintf(stderr, "kernel_launch: unexpected shapes (n_in %d, ws %zu)\n", n_in, ws_size); grid = -1; return; }
        int dev = 0, cus = 0, per_cu = 0;
        if (hipGetDevice(&dev) != hipSuccess || hipDeviceGetAttribute(&cus, hipDeviceAttributeMultiprocessorCount, dev) != hipSuccess) { grid = -1; return; }
        if (hipFuncSetAttribute((const void*)fwd_megakernel, hipFuncAttributeMaxDynamicSharedMemorySize, LDS_BYTES) != hipSuccess) { fprintf(stderr, "kernel_launch: hipFuncSetAttribute failed\n"); grid = -1; return; }
        if (hipOccupancyMaxActiveBlocksPerMultiprocessor(&per_cu, (const void*)fwd_megakernel, NTHREADS, LDS_BYTES) != hipSuccess || per_cu < 1) { fprintf(stderr, "kernel_launch: occupancy query failed (%d)\n", per_cu); (void)hipGetLastError(); grid = -1; return; }
        grid = cus * (per_cu < 1 ? 1 : 1);
        if (grid != 256) { fprintf(stderr, "kernel_launch: built for 256 CUs, device has %d\n", cus); grid = -1; return; }
        for (int c = 0; c < grid; ++c) { pg8::StaticOrder Sg, Sb; Sg.init(M, NGATE, grid, c); Sb.init(M, D, grid, c); pg8::Unit ub, ug; bool ok = true;
            for (int i = 0; Sb.next(i, ub) && ok; ++i) { bool f0 = false, f1 = false;
                for (int k = 0; Sg.next(k, ug); ++k) { if (ug.pm == ub.pm && ug.pn == ub.pn) f0 = true; if (ug.pm == ub.pm && ug.pn == ub.pn + 4) f1 = true; }
                ok = f0 && f1; }
            if (!ok) { fprintf(stderr, "kernel_launch: gate / branch tile ownership mismatch (workgroup %d)\n", c); grid = -1; return; } }
    }
    if (grid < 0) return;
    (void)hipMemsetAsync((char*)d_ws + WS_CTL, 0, CTL_BYTES, stream);
    Args a{};
    a.x = (const float*)d_in[0]; a.c = (const float*)d_in[1]; a.pos = (const int*)d_in[2]; a.ada_w = (const float*)d_in[3]; a.ada_b = (const float*)d_in[4]; a.pre_g = (const float*)d_in[5];
    a.w_in = (const float*)d_in[6]; a.ret_g = (const float*)d_in[7]; a.lq1 = (const float*)d_in[8]; a.lk1 = (const float*)d_in[9]; a.lq2 = (const float*)d_in[10]; a.lk2 = (const float*)d_in[11];
    a.subln_g = (const float*)d_in[12]; a.w_br = (const float*)d_in[13]; a.w_bd = (const float*)d_in[14]; a.w_out = (const float*)d_in[15]; a.post_g = (const float*)d_in[16];
    a.out = (float*)d_out; a.ws = (unsigned char*)d_ws;
    void* args[] = {&a};
    const hipError_t e = hipLaunchCooperativeKernel((const void*)fwd_megakernel, dim3(grid), dim3(NTHREADS), args, LDS_BYTES, stream);
    if (e != hipSuccess) fprintf(stderr, "kernel_launch: cooperative launch failed: %s (grid %d)\n", hipGetErrorString(e), grid);
}
```

```cpp
#include <hip/hip_runtime.h>
#include <hip/hip_cooperative_groups.h>
#include <cstdio>
#include <cstdint>
namespace cg = cooperative_groups;

#define TIDTAB_OFF (147456 - 64)
__device__ __forceinline__ int hw_wave_slot() { return (int)(__builtin_amdgcn_s_getreg((5 << 11) | 4) & 63u); }
__device__ __forceinline__ int lane_now() { int l; asm volatile("v_mbcnt_lo_u32_b32 %0, -1, 0\n\tv_mbcnt_hi_u32_b32 %0, -1, %0" : "=v"(l)); return l; }
__device__ __forceinline__ int tid_now() {
    extern __shared__ __attribute__((aligned(16))) unsigned char lds_raw[];
    const int w = __builtin_amdgcn_readfirstlane((int)((volatile __attribute__((address_space(3))) unsigned char*)lds_raw)[TIDTAB_OFF + hw_wave_slot()]);
    return w * 64 + lane_now();
}
namespace pg8 {
#define PG8_LAS __attribute__((address_space(3)))
typedef unsigned short bf16_t;
typedef short bf16x8 __attribute__((ext_vector_type(8)));
typedef float f32x4 __attribute__((ext_vector_type(4)));
typedef unsigned u32x4 __attribute__((ext_vector_type(4)));
constexpr int BM = 256, BK = 64, HALF = 128, HTB = HALF * BK * 2  , STAGE_BYTES = 8 * HTB, NXCD = 8, WGM = 8;

__host__ __device__ __forceinline__ int lds_byte(int r, int c) { const int st = (r >> 4) * 2 + (c >> 5), rr = r & 15, cc = c & 31, ob = rr * 64 + cc * 2; return st * 1024 + (ob ^ (((ob >> 9) & 1) << 5)); }
__host__ __device__ __forceinline__ void stage_rc(int b, int& R, int& C) { const int st = b / 1024, sb = b % 1024, swz = sb ^ (((sb >> 9) & 1) << 5); R = (st >> 1) * 16 + swz / 64; C = (st & 1) * 32 + (swz % 64) / 2; }
__host__ __device__ __forceinline__ int perm32(int rho) { const int n = rho >> 4, i = rho & 15; return 8 * (i >> 2) + 4 * n + (i & 3); }

struct Unit { int pm, pn; };
struct Gemm { const bf16_t* A; const bf16_t* Bt; int M, N, K; };

struct StaticOrder {
    int nM, nN, nwg, G, c;
    __host__ __device__ void init(int M, int N, int G_, int c_) { nM = M / BM; nN = N / BM; nwg = nM * nN; G = G_; c = c_; }
    __host__ __device__ bool next(int i, Unit& u) const {
        const long L = (long)i * G + c; if (L >= nwg) return false;
        int wgid = (int)L; { const int q = nwg / NXCD, r = nwg % NXCD, xcd = wgid % NXCD, off = wgid / NXCD; wgid = (xcd < r ? xcd * (q + 1) : r * (q + 1) + (xcd - r) * q) + off; }
        const int nig = WGM * nN, gid = wgid / nig, fm = gid * WGM, gsz = (nM - fm) < WGM ? (nM - fm) : WGM;
        u.pm = fm + ((wgid % nig) % gsz); u.pn = (wgid % nig) / gsz; return true;
    }
    __device__ __forceinline__ void a_ready(const Unit&) const {}
    __device__ __forceinline__ void done(const Unit&) const {}
};


typedef float f32x2_t __attribute__((ext_vector_type(2))); typedef __bf16 bf16x2_t __attribute__((ext_vector_type(2)));
__device__ __forceinline__ unsigned cvt_pk_bf16(float lo, float hi) { f32x2_t v = {lo, hi}; bf16x2_t b = __builtin_convertvector(v, bf16x2_t); return __builtin_bit_cast(unsigned, b); }
__device__ __forceinline__ float bf_lo(unsigned w) { return __uint_as_float(w << 16); }
__device__ __forceinline__ float bf_hi(unsigned w) { return __uint_as_float(w & 0xffff0000u); }
__device__ __forceinline__ float sigmoid_f(float x) { return __builtin_amdgcn_rcpf(1.0f + __builtin_amdgcn_exp2f(-1.4426950408889634f * x)); }
__device__ __forceinline__ float silu_f(float x) { return x * sigmoid_f(x); }
__device__ __forceinline__ float sigmoid_l2(float xl2) { return __builtin_amdgcn_rcpf(1.0f + __builtin_amdgcn_exp2f(-xl2)); }
__device__ __forceinline__ u32x4 pack8(const f32x4 v0, const f32x4 v1) { u32x4 w; w.x = cvt_pk_bf16(v0[0], v0[1]); w.y = cvt_pk_bf16(v0[2], v0[3]); w.z = cvt_pk_bf16(v1[0], v1[1]); w.w = cvt_pk_bf16(v1[2], v1[3]); return w; }

struct EpiInProj {
    static constexpr bool PERM = true, AFTER_DRAIN = false;
    static constexpr int NPRE = 2;
    struct Pre { int pv[2]; };
    bf16_t *o0, *o1, *o2, *o3, *o4, *o5, *o6, *o7; const int* pos;
    __device__ __forceinline__ void pre(Pre& P, const Unit& u, int wr, int fr_fq_lane) const {
#pragma unroll
        for (int ai = 0; ai < 2; ++ai) P.pv[ai] = pos[u.pm * BM + ai * HALF + wr * 64 + fr_fq_lane];
    }
    __device__ __forceinline__ void operator()(const f32x4 (&acc)[2][2][4][2], const Unit& u, int wr, int wc, int fr, int fq, const Pre& P) const {
        const int grp = u.pn >> 2, colt = (u.pn & 3) * 256;
        bf16_t* base = grp == 0 ? o0 : grp == 1 ? o1 : grp == 2 ? o2 : grp == 3 ? o3 : grp == 4 ? o4 : grp == 5 ? o5 : grp == 6 ? o6 : o7;
        const int row0 = u.pm * BM + wr * 64 + fr, col0 = colt + wc * 32 + 8 * fq;
        float pp[2][4];
#pragma unroll
        for (int ai = 0; ai < 2; ++ai)
#pragma unroll
            for (int m = 0; m < 4; ++m) pp[ai][m] = (float)__shfl(P.pv[ai], 16 * m + fr);
        if (grp <= 1) {
            float fq8[8];
#pragma unroll
            for (int e = 0; e < 8; ++e) fq8[e] = __builtin_amdgcn_exp2f(-(float)(wc * 32 + 8 * fq + e) * (13.287712379549449f / 128.0f)) * 0.15915494309189535f;
#pragma unroll
            for (int ai = 0; ai < 2; ++ai)
#pragma unroll
                for (int m = 0; m < 4; ++m) {
                    const int row = row0 + ai * HALF + m * 16; const float p = pp[ai][m];
                    f32x4 a0, a1, b0, b1;
#pragma unroll
                    for (int n = 0; n < 2; ++n)
#pragma unroll
                        for (int j = 0; j < 4; ++j) {
                            const float rev = __builtin_amdgcn_fractf(p * fq8[n * 4 + j]);
                            const float sn = __builtin_amdgcn_sinf(rev), cs = __builtin_amdgcn_cosf(rev);
                            const float x1 = acc[ai][0][m][n][j], x2 = acc[ai][1][m][n][j];
                            const float y1 = x1 * cs - x2 * sn, y2 = x2 * cs + x1 * sn;
                            if (n == 0) { a0[j] = y1; b0[j] = y2; } else { a1[j] = y1; b1[j] = y2; }
                        }
                    bf16_t* rowp = base + (size_t)row * 1024 + col0;
                    __builtin_nontemporal_store(pack8(a0, a1), (u32x4*)(rowp)); __builtin_nontemporal_store(pack8(b0, b1), (u32x4*)(rowp + HALF));
                }
        } else if (grp == 4 || grp == 5) {
            const float sc = grp == 4 ? 0.125f * 1.4426950408889634f : 1.0f;
            const bool rot = ((wc & 1) == 0) && (fq < 2);
            float f4[4];
#pragma unroll
            for (int j = 0; j < 4; ++j) f4[j] = __builtin_amdgcn_exp2f(-(float)(4 * (fq & 1) + j) * (18.931568569324174f / 8.0f)) * 0.15915494309189535f;
#pragma unroll
            for (int ai = 0; ai < 2; ++ai)
#pragma unroll
                for (int m = 0; m < 4; ++m) {
                    const int row = row0 + ai * HALF + m * 16; const float p = pp[ai][m];
                    float cs[4], sn[4];
#pragma unroll
                    for (int j = 0; j < 4; ++j) { const float rev = __builtin_amdgcn_fractf(p * f4[j]); sn[j] = rot ? __builtin_amdgcn_sinf(rev) : 0.0f; cs[j] = rot ? __builtin_amdgcn_cosf(rev) : 1.0f; }
                    bf16_t* rowp = (grp == 5) ? base + ((size_t)((row >> 12) * 8 + (colt >> 7)) * 4096 + (row & 4095)) * 128 + wc * 32 + 8 * fq : base + (size_t)row * 1024 + col0;
                    const size_t bjstep = (grp == 5) ? (size_t)4096 * 128 : (size_t)HALF;
#pragma unroll
                    for (int bj = 0; bj < 2; ++bj) {
                        f32x4 v0, v1;
#pragma unroll
                        for (int j = 0; j < 4; ++j) { const float x1 = acc[ai][bj][m][0][j], x2 = acc[ai][bj][m][1][j];
                            v0[j] = (rot ? (x1 * cs[j] - x2 * sn[j]) : x1) * sc; v1[j] = (rot ? (x2 * cs[j] + x1 * sn[j]) : x2) * sc; }
                        __builtin_nontemporal_store(pack8(v0, v1), (u32x4*)(rowp + bj * bjstep));
                    }
                }
        } else {
            const bool act = (grp == 3) || (grp == 7);
#pragma unroll
            for (int ai = 0; ai < 2; ++ai)
#pragma unroll
                for (int m = 0; m < 4; ++m) { const int row = row0 + ai * HALF + m * 16;
                    bf16_t* rowp = (grp == 6) ? base + ((size_t)((row >> 12) * 8 + (colt >> 7)) * 4096 + (row & 4095)) * 128 + wc * 32 + 8 * fq : base + (size_t)row * 1024 + col0;
                    const size_t bjstep = (grp == 6) ? (size_t)4096 * 128 : (size_t)HALF;
#pragma unroll
                    for (int bj = 0; bj < 2; ++bj) { f32x4 v0 = acc[ai][bj][m][0], v1 = acc[ai][bj][m][1];
                        if (act) {
#pragma unroll
                            for (int j = 0; j < 4; ++j) { v0[j] = silu_f(v0[j]); v1[j] = silu_f(v1[j]); } }
                        __builtin_nontemporal_store(pack8(v0, v1), (u32x4*)(rowp + bj * bjstep)); } }
        }
    }
};
struct EpiSigmoid {
    static constexpr bool PERM = true, AFTER_DRAIN = false;
    static constexpr int NPRE = 0; struct Pre {}; __device__ __forceinline__ void pre(Pre&, const Unit&, int, int) const {}
    bf16_t *g0, *g1;
    __device__ __forceinline__ void operator()(const f32x4 (&acc)[2][2][4][2], const Unit& u, int wr, int wc, int fr, int fq, const Pre&) const {
        bf16_t* base = (u.pn >> 2) ? g1 : g0; const int colt = (u.pn & 3) * 256;
        const int row0 = u.pm * BM + wr * 64 + fr, col0 = colt + wc * 32 + 8 * fq;
#pragma unroll
        for (int ai = 0; ai < 2; ++ai)
#pragma unroll
            for (int m = 0; m < 4; ++m) { bf16_t* rowp = base + (size_t)(row0 + ai * HALF + m * 16) * 1024 + col0;
#pragma unroll
                for (int bj = 0; bj < 2; ++bj) { f32x4 v0 = acc[ai][bj][m][0], v1 = acc[ai][bj][m][1];
#pragma unroll
                    for (int j = 0; j < 4; ++j) { v0[j] = sigmoid_l2(v0[j]); v1[j] = sigmoid_l2(v1[j]); }
                    *(u32x4*)(rowp + bj * HALF) = pack8(v0, v1); } }
    }
};
template <bool ADD> struct EpiGate {
    static constexpr bool PERM = true, AFTER_DRAIN = false;
    static constexpr int NPRE = 0; struct Pre {}; __device__ __forceinline__ void pre(Pre&, const Unit&, int, int) const {}
    const bf16_t* G; const bf16_t* T; bf16_t* O;
    __device__ __forceinline__ void operator()(const f32x4 (&acc)[2][2][4][2], const Unit& u, int wr, int wc, int fr, int fq, const Pre&) const {
        const int row0 = u.pm * BM + wr * 64 + fr, col0 = u.pn * BM + wc * 32 + 8 * fq;
        f32x4 r[2][2][4][2];
        if (!ADD) {
            u32x4 gv[2][4][2];
#pragma unroll
            for (int ai = 0; ai < 2; ++ai)
#pragma unroll
                for (int m = 0; m < 4; ++m)
#pragma unroll
                    for (int bj = 0; bj < 2; ++bj) gv[ai][m][bj] = *(const u32x4*)(G + (size_t)(row0 + ai * HALF + m * 16) * 1024 + col0 + bj * HALF);
#pragma unroll
            for (int ai = 0; ai < 2; ++ai)
#pragma unroll
                for (int m = 0; m < 4; ++m)
#pragma unroll
                    for (int bj = 0; bj < 2; ++bj) { const u32x4 g = gv[ai][m][bj]; f32x4 v0 = acc[ai][bj][m][0], v1 = acc[ai][bj][m][1];
                        v0[0] *= bf_lo(g.x); v0[1] *= bf_hi(g.x); v0[2] *= bf_lo(g.y); v0[3] *= bf_hi(g.y);
                        v1[0] *= bf_lo(g.z); v1[1] *= bf_hi(g.z); v1[2] *= bf_lo(g.w); v1[3] *= bf_hi(g.w);
                        r[ai][bj][m][0] = v0; r[ai][bj][m][1] = v1; }
        } else {
#pragma unroll
            for (int ai = 0; ai < 2; ++ai) {
                u32x4 gv[4][2], tv[4][2];
#pragma unroll
                for (int m = 0; m < 4; ++m)
#pragma unroll
                    for (int bj = 0; bj < 2; ++bj) { const size_t off = (size_t)(row0 + ai * HALF + m * 16) * 1024 + col0 + bj * HALF; gv[m][bj] = *(const u32x4*)(G + off); tv[m][bj] = *(const u32x4*)(T + off); }
#pragma unroll
                for (int m = 0; m < 4; ++m)
#pragma unroll
                    for (int bj = 0; bj < 2; ++bj) { const u32x4 g = gv[m][bj], t = tv[m][bj]; f32x4 v0 = acc[ai][bj][m][0], v1 = acc[ai][bj][m][1];
                        v0[0] = v0[0] * bf_lo(g.x) + bf_lo(t.x); v0[1] = v0[1] * bf_hi(g.x) + bf_hi(t.x); v0[2] = v0[2] * bf_lo(g.y) + bf_lo(t.y); v0[3] = v0[3] * bf_hi(g.y) + bf_hi(t.y);
                        v1[0] = v1[0] * bf_lo(g.z) + bf_lo(t.z); v1[1] = v1[1] * bf_hi(g.z) + bf_hi(t.z); v1[2] = v1[2] * bf_lo(g.w) + bf_lo(t.w); v1[3] = v1[3] * bf_hi(g.w) + bf_hi(t.w);
                        r[ai][bj][m][0] = v0; r[ai][bj][m][1] = v1; }
                asm volatile("" ::: "memory");
            }
        }
        asm volatile("" ::: "memory");
#pragma unroll
        for (int ai = 0; ai < 2; ++ai)
#pragma unroll
            for (int m = 0; m < 4; ++m)
#pragma unroll
                for (int bj = 0; bj < 2; ++bj) *(u32x4*)(O + (size_t)(row0 + ai * HALF + m * 16) * 1024 + col0 + bj * HALF) = pack8(r[ai][bj][m][0], r[ai][bj][m][1]);
    }
};
struct EpiOutSsq {
    static constexpr bool PERM = true, AFTER_DRAIN = false;
    static constexpr int NPRE = 0; struct Pre {}; __device__ __forceinline__ void pre(Pre&, const Unit&, int, int) const {}
    bf16_t* O; float* ssq;
    __device__ __forceinline__ void operator()(const f32x4 (&acc)[2][2][4][2], const Unit& u, int wr, int wc, int fr, int fq, const Pre&) const {
        const int row0 = u.pm * BM + wr * 64 + fr, col0 = u.pn * BM + wc * 32 + 8 * fq;
#pragma unroll
        for (int ai = 0; ai < 2; ++ai)
#pragma unroll
            for (int m = 0; m < 4; ++m) { const int row = row0 + ai * HALF + m * 16; const size_t off = (size_t)row * 1024 + col0; float s = 0.f;
#pragma unroll
                for (int bj = 0; bj < 2; ++bj) { const f32x4 v0 = acc[ai][bj][m][0], v1 = acc[ai][bj][m][1];
                    s += (v0[0] * v0[0] + v0[1] * v0[1]) + (v0[2] * v0[2] + v0[3] * v0[3]) + (v1[0] * v1[0] + v1[1] * v1[1]) + (v1[2] * v1[2] + v1[3] * v1[3]);
                    *(u32x4*)(O + off + bj * HALF) = pack8(v0, v1); }
                s += __shfl_xor(s, 16); s += __shfl_xor(s, 32);
                if (fq == 0) ssq[(size_t)row * 16 + u.pn * 4 + wc] = s; }
    }
};

template <class Epi, class Sched, bool ALIGN_EPI = false, bool SP2 = false>
__device__ __forceinline__ void gemm_phase(PG8_LAS unsigned char* lds, const Gemm g, const Sched& S, const Epi& E) {
    int tid_ = tid_now(); asm volatile("" : "+v"(tid_));
    const int tid = tid_, wid = __builtin_amdgcn_readfirstlane(tid >> 6), lane = tid & 63, wr = wid >> 2, wc = wid & 3, fr = lane & 15, fq = lane >> 4;
    const int K = g.K, nt = K / BK;
    unsigned voffA[2], voffB[2];
#pragma unroll
    for (int i = 0; i < 2; ++i) { int R, C; stage_rc(tid * 16 + i * 8192, R, C); const int Rb = Epi::PERM ? ((R & ~31) + perm32(R & 31)) : R;
        voffA[i] = (unsigned)(R * K + C) * 2u; voffB[i] = (unsigned)(Rb * K + C) * 2u; }
    const size_t kstep = (size_t)(BK * 2);
    const size_t hstep = (size_t)HALF * K * 2;
    const size_t tstep = 2 * hstep;
    const unsigned ldsw = (unsigned)wid * 1024u;
    const int aoff = lds_byte(wr * 64 + fr, fq * 8), boff = lds_byte(wc * 32 + fr, fq * 8);
#define PG8_SA(b, h) (((b) * 2 + (h)) * HTB)
#define PG8_SB(b, h) ((4 + (b) * 2 + (h)) * HTB)
#define PG8_STAGE(bufoff, gbase, voff) do { _Pragma("unroll") for (int _i = 0; _i < 2; ++_i) \
        __builtin_amdgcn_global_load_lds((const unsigned*)((const char*)(gbase) + (voff)[_i]), (PG8_LAS unsigned*)(lds + (bufoff) + ldsw + _i * 8192), 16, 0, 0); } while (0)
#define PG8_LDA(dst, b, h) do { _Pragma("unroll") for (int m = 0; m < 4; ++m) _Pragma("unroll") for (int k = 0; k < 2; ++k) dst[m][k] = *(const PG8_LAS bf16x8*)(lds + PG8_SA(b, h) + aoff + m * 2048 + k * 1024); } while (0)
#define PG8_LDB(dst, b, h) do { _Pragma("unroll") for (int n = 0; n < 2; ++n) _Pragma("unroll") for (int k = 0; k < 2; ++k) dst[n][k] = *(const PG8_LAS bf16x8*)(lds + PG8_SB(b, h) + boff + n * 2048 + k * 1024); } while (0)
#define PG8_MMA(ai, bj, At, Bt) do { __builtin_amdgcn_s_setprio(1); _Pragma("unroll") for (int m = 0; m < 4; ++m) _Pragma("unroll") for (int n = 0; n < 2; ++n) _Pragma("unroll") for (int k = 0; k < 2; ++k) \
        acc[ai][bj][m][n] = __builtin_amdgcn_mfma_f32_16x16x32_bf16(Bt[n][k], At[m][k], acc[ai][bj][m][n], 0, 0, 0); __builtin_amdgcn_s_setprio(0); } while (0)
#define PG8_WAIT_V(n) asm volatile("s_waitcnt vmcnt(" #n ")" ::: "memory")
#define PG8_WAIT_L(n) asm volatile("s_waitcnt lgkmcnt(" #n ")" ::: "memory")
#define PG8_BAR __builtin_amdgcn_s_barrier()
#define PG8_SCHED __builtin_amdgcn_sched_barrier(0)
    Unit cur, nxt; int ui = 0;
    if (!S.next(0, cur)) return;
    typename Epi::Pre pre{};
    f32x4 acc[2][2][4][2];
#pragma unroll
    for (int a = 0; a < 2; ++a)
#pragma unroll
        for (int b = 0; b < 2; ++b)
#pragma unroll
            for (int m = 0; m < 4; ++m)
#pragma unroll
                for (int n = 0; n < 2; ++n) acc[a][b][m][n] = (f32x4){0.f, 0.f, 0.f, 0.f};
    bf16x8 At[4][2], B0[2][2], B1[2][2];
    const char* cA = (const char*)g.A + (size_t)cur.pm * tstep; const char* cB = (const char*)g.Bt + (size_t)cur.pn * tstep;
    S.a_ready(cur);
    if constexpr (SP2) {
        PG8_STAGE(PG8_SB(0, 0), cB, voffB); PG8_STAGE(PG8_SB(0, 1), cB + hstep, voffB); PG8_STAGE(PG8_SA(0, 0), cA, voffA); PG8_STAGE(PG8_SA(0, 1), cA + hstep, voffA);
        if (wr == 1) PG8_BAR;
        PG8_WAIT_V(2); PG8_BAR;
        PG8_STAGE(PG8_SB(1, 0), cB + kstep, voffB); PG8_STAGE(PG8_SA(1, 0), cA + kstep, voffA); PG8_STAGE(PG8_SB(1, 1), cB + hstep + kstep, voffB);
        PG8_WAIT_V(6); PG8_BAR;
    } else {
        PG8_STAGE(PG8_SB(0, 0), cB, voffB); PG8_STAGE(PG8_SA(0, 0), cA, voffA); PG8_STAGE(PG8_SB(0, 1), cB + hstep, voffB); PG8_STAGE(PG8_SA(0, 1), cA + hstep, voffA);
        if (wr == 1) PG8_BAR;
        PG8_WAIT_V(4); PG8_BAR;
        PG8_STAGE(PG8_SB(1, 0), cB + kstep, voffB); PG8_STAGE(PG8_SA(1, 0), cA + kstep, voffA); PG8_STAGE(PG8_SB(1, 1), cB + hstep + kstep, voffB);
        PG8_WAIT_V(6); PG8_BAR;
    }
    for (;;) {
        const bool has_next = S.next(ui + 1, nxt);
        const char* nA = has_next ? (const char*)g.A + (size_t)nxt.pm * tstep : cA; const char* nB = has_next ? (const char*)g.Bt + (size_t)nxt.pn * tstep : cB;
        for (int t = 0; t < nt; t += 2) {
            const bool last = (t == nt - 2);
            const char* a1 = cA + (size_t)(t + 1) * kstep;
            const char* a2 = last ? nA : cA + (size_t)(t + 2) * kstep; const char* b2 = last ? nB : cB + (size_t)(t + 2) * kstep;
            const char* a3 = a2 + kstep; const char* b3 = b2 + kstep;
            if (last && has_next) S.a_ready(nxt);
            if constexpr (SP2) {
            PG8_LDB(B0, 0, 0); PG8_LDB(B1, 0, 1); PG8_SCHED; PG8_LDA(At, 0, 0);
            if (Epi::NPRE > 0 && last) E.pre(pre, cur, wr, lane);
            PG8_STAGE(PG8_SA(1, 1), a1 + hstep, voffA);
            if (Epi::NPRE > 0 && last) asm volatile("s_waitcnt vmcnt(%0)" :: "n"(8 + Epi::NPRE) : "memory"); else PG8_WAIT_V(8);
            PG8_WAIT_L(0); PG8_BAR; PG8_MMA(0, 0, At, B0); PG8_MMA(0, 1, At, B1); PG8_BAR; PG8_SCHED;
            PG8_LDA(At, 0, 1); PG8_STAGE(PG8_SB(0, 0), b2, voffB); PG8_STAGE(PG8_SB(0, 1), b2 + hstep, voffB); PG8_STAGE(PG8_SA(0, 0), a2, voffA);
            PG8_WAIT_V(8); PG8_WAIT_L(0); PG8_BAR; PG8_MMA(1, 0, At, B0); PG8_MMA(1, 1, At, B1); PG8_BAR; PG8_SCHED;
            PG8_LDB(B0, 1, 0); PG8_LDB(B1, 1, 1); PG8_SCHED; PG8_LDA(At, 1, 0); PG8_STAGE(PG8_SA(0, 1), a2 + hstep, voffA);
            PG8_WAIT_V(8); PG8_WAIT_L(0); PG8_BAR; PG8_MMA(0, 0, At, B0); PG8_MMA(0, 1, At, B1); PG8_BAR; PG8_SCHED;
            PG8_LDA(At, 1, 1); PG8_STAGE(PG8_SB(1, 0), b3, voffB); PG8_STAGE(PG8_SB(1, 1), b3 + hstep, voffB); PG8_STAGE(PG8_SA(1, 0), a3, voffA);
            PG8_WAIT_V(8); PG8_WAIT_L(0); PG8_BAR; PG8_MMA(1, 0, At, B0); PG8_MMA(1, 1, At, B1); PG8_BAR; PG8_SCHED;
            } else {
            PG8_LDB(B0, 0, 0); PG8_SCHED; PG8_LDA(At, 0, 0); PG8_STAGE(PG8_SA(1, 1), a1 + hstep, voffA);
            PG8_WAIT_L(8); PG8_BAR; PG8_WAIT_L(0); PG8_MMA(0, 0, At, B0); PG8_BAR; PG8_SCHED;
            PG8_LDB(B1, 0, 1); PG8_STAGE(PG8_SB(0, 0), b2, voffB);
            PG8_BAR; PG8_WAIT_L(0); PG8_MMA(0, 1, At, B1); PG8_BAR;
            PG8_LDA(At, 0, 1); PG8_STAGE(PG8_SA(0, 0), a2, voffA);
            PG8_BAR; PG8_WAIT_L(0); PG8_MMA(1, 0, At, B0); PG8_BAR; PG8_SCHED;
            PG8_STAGE(PG8_SB(0, 1), b2 + hstep, voffB);
            PG8_WAIT_V(6); PG8_BAR; PG8_MMA(1, 1, At, B1); PG8_BAR;
            PG8_LDB(B0, 1, 0); PG8_SCHED; PG8_LDA(At, 1, 0); PG8_STAGE(PG8_SA(0, 1), a2 + hstep, voffA);
            PG8_WAIT_L(8); PG8_BAR; PG8_WAIT_L(0); PG8_MMA(0, 0, At, B0); PG8_BAR; PG8_SCHED;
            PG8_LDB(B1, 1, 1); PG8_STAGE(PG8_SB(1, 0), b3, voffB);
            PG8_BAR; PG8_WAIT_L(0); PG8_MMA(0, 1, At, B1); PG8_BAR;
            PG8_LDA(At, 1, 1); PG8_STAGE(PG8_SA(1, 0), a3, voffA);
            PG8_BAR; PG8_WAIT_L(0); PG8_MMA(1, 0, At, B0); PG8_BAR; PG8_SCHED;
            PG8_STAGE(PG8_SB(1, 1), b3 + hstep, voffB);
            PG8_WAIT_V(6); PG8_BAR; PG8_MMA(1, 1, At, B1); PG8_BAR;
            }
        }
        if constexpr (ALIGN_EPI) { if (wr == 0) PG8_BAR; }
        if constexpr (!Epi::AFTER_DRAIN) { E(acc, cur, wr, wc, fr, fq, pre); S.done(cur); }
        if (!has_next) break;
#pragma unroll
        for (int a = 0; a < 2; ++a)
#pragma unroll
            for (int b = 0; b < 2; ++b)
#pragma unroll
                for (int m = 0; m < 4; ++m)
#pragma unroll
                    for (int n = 0; n < 2; ++n) acc[a][b][m][n] = (f32x4){0.f, 0.f, 0.f, 0.f};
        cur = nxt; cA = nA; cB = nB; ++ui;
        if constexpr (ALIGN_EPI) { if (wr == 1) PG8_BAR; }
    }
    PG8_WAIT_V(0);
    if constexpr (!ALIGN_EPI) { if (wr == 0) PG8_BAR; }
    PG8_BAR;
    if constexpr (Epi::AFTER_DRAIN) { E.fused(acc, cur, wr, wc, fr, fq, lds, wid, lane); S.done(cur); }
#undef PG8_SA
#undef PG8_SB
#undef PG8_STAGE
#undef PG8_LDA
#undef PG8_LDB
#undef PG8_MMA
#undef PG8_WAIT_V
#undef PG8_WAIT_L
#undef PG8_BAR
#undef PG8_SCHED
}
}

constexpr int NWAVES = 8, NTHREADS = 512;
constexpr int D = 1024, BATCH = 8, SEQ = 4096, M = BATCH * SEQ, CHUNK = 64;
constexpr int NPROJ = 10240, NMIX = 8192, NGATE = 2048;
constexpr size_t MiB = 1u << 20;
constexpr size_t WS_CTL = 0, CTL_BYTES = 32768;
constexpr int CW_BAR = 1024;
constexpr size_t WS_MODP = 1 * MiB;
constexpr size_t WS_WIN = 4 * MiB;
constexpr size_t WS_WR = 24 * MiB, WS_WD = 26 * MiB, WS_WO = 28 * MiB;
constexpr size_t WS_SSQ = 30 * MiB;
constexpr size_t WS_H = 32 * MiB;
constexpr size_t WS_RQ = 96 * MiB;
constexpr size_t WS_RK = 160 * MiB;
constexpr size_t WS_RV = 224 * MiB;
constexpr size_t WS_RG = 288 * MiB;
constexpr size_t WS_DQ = 352 * MiB;
constexpr size_t WS_DK = 416 * MiB;
constexpr size_t WS_END = 480 * MiB;
constexpr int REP_P0 = 1, REP_P1 = 1, REP_P2 = 1, REP_P4 = 1, REP_P5 = 1, REP_P6 = 1, REP_P7 = 1;
constexpr int LDS_BYTES = 147456;

#define LAS __attribute__((address_space(3)))
typedef unsigned short bf16;
typedef short bf16x8 __attribute__((ext_vector_type(8)));
typedef short s16x4 __attribute__((ext_vector_type(4)));
typedef float f32x4 __attribute__((ext_vector_type(4)));
typedef float f32x16 __attribute__((ext_vector_type(16)));
typedef unsigned u32x4 __attribute__((ext_vector_type(4)));
typedef unsigned u32x2 __attribute__((ext_vector_type(2)));
typedef short v4i16_t __attribute__((ext_vector_type(4)));

__device__ __forceinline__ unsigned f2bf(float f) { unsigned u = __builtin_bit_cast(unsigned, f); return (u + 0x7fffu + ((u >> 16) & 1u)) >> 16; }
__device__ __forceinline__ unsigned pk2(float lo, float hi) { return f2bf(lo) | (f2bf(hi) << 16); }
__device__ __forceinline__ unsigned cvtpk(float lo, float hi) { return pg8::cvt_pk_bf16(lo, hi); }
__device__ __forceinline__ float bflo(unsigned w) { return __uint_as_float(w << 16); }
__device__ __forceinline__ float bfhi(unsigned w) { return __uint_as_float(w & 0xffff0000u); }
__device__ __forceinline__ int crow(int r, int hi) { return (r & 3) + 8 * (r >> 2) + 4 * hi; }
__device__ __forceinline__ s16x4 tr_read(const LAS unsigned char* p) { return __builtin_bit_cast(s16x4, __builtin_amdgcn_ds_read_tr16_b64_v4i16((LAS v4i16_t*)p)); }
__device__ __forceinline__ bf16x8 cat8(s16x4 lo, s16x4 hi) { return (bf16x8){lo[0], lo[1], lo[2], lo[3], hi[0], hi[1], hi[2], hi[3]}; }
__device__ __forceinline__ float wave_sum(float v) {
    const int ln = lane_now();
#pragma unroll
    for (int o = 1; o < 64; o <<= 1) v += __uint_as_float((unsigned)__builtin_amdgcn_ds_bpermute((ln ^ o) << 2, (int)__float_as_uint(v)));
    return v;
}

struct Args {
    const float* x; const float* c; const int* pos; const float* ada_w; const float* ada_b; const float* pre_g; const float* w_in; const float* ret_g;
    const float* lq1; const float* lk1; const float* lq2; const float* lk2; const float* subln_g; const float* w_br; const float* w_bd; const float* w_out; const float* post_g;
    float* out; unsigned char* ws;
};

#define XB_TMO      128
#define XB_XCNT(j)  (256  + 64 * (j))
#define XB_XSUB(j)  (1280 + 64 * (j))
#define XB_XGEN(j)  (2304 + 64 * (j))
#define XB_TOP      3328
#define XB_TOPGEN   3392
#define XCD_BAR_WORDS 3456
#define XB_SPIN_CAP (1u << 18)

__device__ __forceinline__ unsigned xb_ld(unsigned* p)              { return __hip_atomic_load(p, __ATOMIC_RELAXED, __HIP_MEMORY_SCOPE_AGENT); }
__device__ __forceinline__ unsigned xb_add(unsigned* p, unsigned v) { return __hip_atomic_fetch_add(p, v, __ATOMIC_RELAXED, __HIP_MEMORY_SCOPE_AGENT); }
__device__ __forceinline__ unsigned xb_xcc_id() { return (unsigned)__builtin_amdgcn_s_getreg((3 << 11) | 20) & 0xFu; }
#define XB_SPIN(cond, bar) do { unsigned _sp = 0; while (cond) { __builtin_amdgcn_s_sleep(1); \
    if ((++_sp & 255u) == 0u) { if (xb_ld(&(bar)[XB_TMO])) break; if (_sp > XB_SPIN_CAP) { atomicAdd(&(bar)[XB_TMO], 1u); break; } } } } while (0)

struct XcdBarrier {
    unsigned* bar; unsigned x;
    volatile LAS unsigned* st;
};

__device__ __forceinline__ XcdBarrier xcd_barrier_post(unsigned* bar, volatile LAS unsigned* st) {
    XcdBarrier b; b.bar = bar; b.x = xb_xcc_id(); b.st = st;
    if (tid_now() == 0) (void)xb_add(&bar[XB_XCNT(b.x)], 1u);
    return b;
}
__device__ __forceinline__ void xcd_barrier_complete(unsigned* bar, unsigned x, unsigned& nloc, unsigned& nx) {
    const unsigned G = gridDim.x * gridDim.y * gridDim.z;
    unsigned sum, cnt, mine, sp = 0u;
    for (;;) {
        sum = 0u; cnt = 0u; mine = 0u;
#pragma unroll
        for (unsigned j = 0; j < 16; ++j) { const unsigned c = xb_ld(&bar[XB_XCNT(j)]); sum += c; cnt += (c > 0u) ? 1u : 0u; mine = (j == x) ? c : mine; }
        if (sum == G) break;
        __builtin_amdgcn_s_sleep(1);
        if ((++sp & 255u) == 0u) { if (xb_ld(&bar[XB_TMO])) break; if (sp > XB_SPIN_CAP) { atomicAdd(&bar[XB_TMO], 1u); break; } }
    }
    nloc = mine > 0u ? mine : 1u; nx = cnt > 0u ? cnt : 1u;
}

__device__ __forceinline__ void xcd_barrier(const XcdBarrier& b) {
    asm volatile("s_waitcnt vmcnt(0)" ::: "memory");
    __syncthreads();
    if (tid_now() == 0) {
        unsigned* bar = b.bar;
        __builtin_amdgcn_s_waitcnt(0);
        unsigned nloc = b.st[0], nx = b.st[1];
        if (nloc == 0u) { xcd_barrier_complete(bar, b.x, nloc, nx); b.st[0] = nloc; b.st[1] = nx; }
        const unsigned old = xb_add(&bar[XB_XSUB(b.x)], 1u);
        const unsigned gen = old / nloc;
        if (old + 1u == (gen + 1u) * nloc) {
            __builtin_amdgcn_fence(__ATOMIC_RELEASE, "agent");
            asm volatile("s_waitcnt vmcnt(0)" ::: "memory");
            const unsigned og = xb_add(&bar[XB_TOP], 1u);
            const unsigned tg = og / nx;
            if (og + 1u == (tg + 1u) * nx) xb_add(&bar[XB_TOPGEN], 1u);
            else XB_SPIN(xb_ld(&bar[XB_TOPGEN]) == tg, bar);
            __builtin_amdgcn_fence(__ATOMIC_ACQUIRE, "agent");
            xb_add(&bar[XB_XGEN(b.x)], 1u);
            asm volatile("s_waitcnt vmcnt(0)" ::: "memory");
        } else {
            XB_SPIN(xb_ld(&bar[XB_XGEN(b.x)]) == gen, bar);
            __builtin_amdgcn_fence(__ATOMIC_ACQUIRE, "agent");
            asm volatile("s_waitcnt vmcnt(0)" ::: "memory");
        }
    }
    __syncthreads();
}

template <bool PERMQK>
__device__ __forceinline__ void p0_transpose_item(const float* W, int K, int N, bf16* WT, LAS float* scr, int item, int lane) {
    const int nblk = N / 32, kb = item / nblk, nb = item % nblk, k0 = 64 * kb, n0 = 32 * nb;
    int nsrc = n0 + (lane & 31);
    if (PERMQK) { if (nsrc >= 4096 && nsrc < 6144 && (nsrc & 63) < 16) { const int p = nsrc & 15; nsrc = (nsrc & ~15) | (p & 3) | ((p & 4) << 1) | ((p & 8) >> 1); } }
    float wv[32];
#pragma unroll
    for (int i = 0; i < 32; ++i) wv[i] = __builtin_nontemporal_load(W + (size_t)(k0 + 2 * i + (lane >> 5)) * N + nsrc);
    const float csc = !PERMQK ? 1.0f : (nsrc >= 1024 && nsrc < 2048) ? 0.0625f : (nsrc >= 8192) ? 1.4426950408889634f : 1.0f;
#pragma unroll
    for (int i = 0; i < 32; ++i) scr[(2 * i + (lane >> 5)) * 33 + (lane & 31)] = wv[i] * csc;
    asm volatile("s_waitcnt lgkmcnt(0)" ::: "memory");
    const int c = lane & 7;
#pragma unroll
    for (int j = 0; j < 4; ++j) { const int n = (lane >> 3) + 8 * j; const LAS float* s = scr + (8 * c) * 33 + n;
        u32x4 o; o.x = pk2(s[0 * 33], s[1 * 33]); o.y = pk2(s[2 * 33], s[3 * 33]); o.z = pk2(s[4 * 33], s[5 * 33]); o.w = pk2(s[6 * 33], s[7 * 33]);
        *(u32x4*)(WT + (size_t)(n0 + n) * K + k0 + 8 * c) = o; }
    asm volatile("s_waitcnt lgkmcnt(0)" ::: "memory");
}
__device__ __forceinline__ void p0_mod_item(const float* c, const float* ada_w, float* modp, int item, int lane) {
    const int jg = item % 48, ks = item / 48, j = jg * 64 + lane;
    float w[64];
#pragma unroll
    for (int kk = 0; kk < 64; ++kk) w[kk] = __builtin_nontemporal_load(ada_w + (size_t)(ks * 64 + kk) * 3072 + j);
    const int kq = ks * 64 + lane;
    float sc[8], acc[8];
#pragma unroll
    for (int b = 0; b < 8; ++b) { sc[b] = pg8::silu_f(c[b * 1024 + kq]); acc[b] = 0.f; }
#pragma unroll
    for (int kk = 0; kk < 64; ++kk)
#pragma unroll
        for (int b = 0; b < 8; ++b) acc[b] += __uint_as_float((unsigned)__builtin_amdgcn_readlane((int)__float_as_uint(sc[b]), kk)) * w[kk];
    float* o = modp + (size_t)ks * 8 * 3072 + j;
#pragma unroll
    for (int b = 0; b < 8; ++b) o[b * 3072] = acc[b];
}
__device__ __forceinline__ float mod_value(const float* modp, const float* ada_b, int b, int j) {
    float s = 0.f;
#pragma unroll
    for (int ks = 0; ks < 16; ++ks) s += modp[((size_t)ks * 8 + b) * 3072 + j];
    return s + ada_b[j];
}

constexpr int AT_SLOT = 32768, AT_WS = 4 * AT_SLOT, AT_EP = 0, AT_EPP = 132;
__device__ __forceinline__ void glds16(const void* gsrc, unsigned lds_dst) { unsigned keep;
    asm volatile("s_mov_b32 %0, m0\n\ts_mov_b32 m0, %2\n\ts_nop 0\n\tglobal_load_lds_dwordx4 %1, off\n\ts_mov_b32 m0, %0" : "=&s"(keep) : "v"(gsrc), "s"(lds_dst) : "memory"); }
__device__ __forceinline__ void glds16s(const void* sbase, unsigned voff, unsigned lds_dst) { unsigned keep;
    asm volatile("s_mov_b32 %0, m0\n\ts_mov_b32 m0, %3\n\ts_nop 0\n\tglobal_load_lds_dwordx4 %1, %2\n\ts_mov_b32 m0, %0" : "=&s"(keep) : "v"(voff), "s"(sbase), "s"(lds_dst) : "memory"); }
#define AT_WAIT_BAR(N) asm volatile("s_waitcnt vmcnt(" #N ") lgkmcnt(0)\n\ts_barrier" ::: "memory")
#define AT_Z16 (f32x16){0.f, 0.f, 0.f, 0.f, 0.f, 0.f, 0.f, 0.f, 0.f, 0.f, 0.f, 0.f, 0.f, 0.f, 0.f, 0.f}
#define AT_SB() __builtin_amdgcn_sched_barrier(0)
__device__ __forceinline__ float at_max3(float a, float b, float c) { float r; asm("v_max3_f32 %0, %1, %2, %3" : "=v"(r) : "v"(a), "v"(b), "v"(c)); return r; }
__device__ __forceinline__ float at_max2(float a, float b) { float r; asm("v_max_f32_e32 %0, %1, %2" : "=v"(r) : "v"(a), "v"(b)); return r; }
__device__ __forceinline__ float at_add(float a, float b) { float r; asm("v_add_f32_e32 %0, %1, %2" : "=v"(r) : "v"(a), "v"(b)); return r; }
__device__ __forceinline__ float at_rowmax(const f32x16& p0, const f32x16& p1) {
    float a = at_max3(p0[0], p0[1], p1[0]), b = at_max3(p0[2], p0[3], p1[1]); a = at_max3(a, p1[2], p1[3]);
#pragma unroll
    for (int r = 4; r < 16; r += 4) { a = at_max3(a, p0[r], p0[r + 1]); b = at_max3(b, p0[r + 2], p0[r + 3]); a = at_max3(a, p1[r], p1[r + 1]); b = at_max3(b, p1[r + 2], p1[r + 3]); }
    const float m = at_max2(a, b);
    const auto rr = __builtin_amdgcn_permlane32_swap(__float_as_uint(m), __float_as_uint(m), false, false);
    return at_max2(__uint_as_float(rr[0]), __uint_as_float(rr[1]));
}
__device__ __forceinline__ void at_first(const LAS unsigned char* sbK, int koff, const bf16x8 (&qf)[4], bf16x8 (&pa)[4], float& m_run, f32x16& negm) {
    f32x16 p0, p1;
#pragma unroll
    for (int s = 0; s < 4; ++s) {
        const LAS unsigned char* kp = sbK + (koff ^ (s * 32));
        const bf16x8 a0 = *(const LAS bf16x8*)kp, a1 = *(const LAS bf16x8*)(kp + 8192);
        if (s == 0) { p0 = __builtin_amdgcn_mfma_f32_32x32x16_bf16(a0, qf[0], AT_Z16, 0, 0, 0); p1 = __builtin_amdgcn_mfma_f32_32x32x16_bf16(a1, qf[0], AT_Z16, 0, 0, 0); }
        else { p0 = __builtin_amdgcn_mfma_f32_32x32x16_bf16(a0, qf[s], p0, 0, 0, 0); p1 = __builtin_amdgcn_mfma_f32_32x32x16_bf16(a1, qf[s], p1, 0, 0, 0); }
    }
    const float mx = at_rowmax(p0, p1);
    m_run = mx;
#pragma unroll
    for (int r = 0; r < 16; ++r) negm[r] = -mx;
    unsigned pw[16];
#pragma unroll
    for (int j = 0; j < 8; ++j) { pw[j] = cvtpk(__builtin_amdgcn_exp2f(p0[2 * j] - mx), __builtin_amdgcn_exp2f(p0[2 * j + 1] - mx)); pw[8 + j] = cvtpk(__builtin_amdgcn_exp2f(p1[2 * j] - mx), __builtin_amdgcn_exp2f(p1[2 * j + 1] - mx)); }
#pragma unroll
    for (int k = 0; k < 4; ++k) pa[k] = __builtin_bit_cast(bf16x8, (u32x4){pw[4 * k], pw[4 * k + 1], pw[4 * k + 2], pw[4 * k + 3]});
}
template <bool NEXT, bool MASKABLE = false>
__device__ __forceinline__ void at_step(const LAS unsigned char* sbK, const LAS unsigned char* sbV, int koff, int r32, int hi, int vb, int vx, const bf16x8 (&qf)[4], f32x16 (&o)[4], float& l_run,
                                        bf16x8 (&pc)[4], float& m_run, f32x16& negm, LAS float* wsf, int late, bool mask_next = false) {
    f32x16 pS0, pS1;
    bool resc = false; float alpha = 1.0f;
    if (NEXT && late) __builtin_amdgcn_s_setprio(1);
    typedef __bf16 at_bf2 __attribute__((ext_vector_type(2)));
#define AT_RS(k_) do { const u32x4 w_ = __builtin_bit_cast(u32x4, pc[(k_) >> 1]); const at_bf2 one2_ = __builtin_bit_cast(at_bf2, 0x3F803F80u); \
        rs0 = __builtin_amdgcn_fdot2_f32_bf16(__builtin_bit_cast(at_bf2, ((k_) & 1) ? w_.z : w_.x), one2_, rs0, false); \
        rs1 = __builtin_amdgcn_fdot2_f32_bf16(__builtin_bit_cast(at_bf2, ((k_) & 1) ? w_.w : w_.y), one2_, rs1, false); } while (0)
    float rs0 = 0.f, rs1 = 0.f;
    if (NEXT) {
        bf16x8 kf[8];
#define AT_KLD(s_) do { const LAS unsigned char* kp_ = sbK + (koff ^ ((s_) * 32)); kf[2 * (s_)] = *(const LAS bf16x8*)kp_; kf[2 * (s_) + 1] = *(const LAS bf16x8*)(kp_ + 8192); } while (0)
        AT_KLD(0); AT_KLD(1);
        pS0 = __builtin_amdgcn_mfma_f32_32x32x16_bf16(kf[0], qf[0], negm, 0, 0, 0);
        pS1 = __builtin_amdgcn_mfma_f32_32x32x16_bf16(kf[1], qf[0], negm, 0, 0, 0);
        AT_KLD(2);
        pS0 = __builtin_amdgcn_mfma_f32_32x32x16_bf16(kf[2], qf[1], pS0, 0, 0, 0);
        pS1 = __builtin_amdgcn_mfma_f32_32x32x16_bf16(kf[3], qf[1], pS1, 0, 0, 0);
        AT_KLD(3);
        pS0 = __builtin_amdgcn_mfma_f32_32x32x16_bf16(kf[4], qf[2], pS0, 0, 0, 0);
        pS1 = __builtin_amdgcn_mfma_f32_32x32x16_bf16(kf[5], qf[2], pS1, 0, 0, 0);
        pS0 = __builtin_amdgcn_mfma_f32_32x32x16_bf16(kf[6], qf[3], pS0, 0, 0, 0);
        pS1 = __builtin_amdgcn_mfma_f32_32x32x16_bf16(kf[7], qf[3], pS1, 0, 0, 0);
#undef AT_KLD
        if (MASKABLE) { if (mask_next) {
#pragma unroll
            for (int r = 0; r < 16; ++r) { pS0[r] = -1e30f; pS1[r] = -1e30f; } } }
        const float mx = at_rowmax(pS0, pS1);
        if (__any(mx > 8.0f)) {
            const float dl = fmaxf(mx, 0.f); m_run += dl; alpha = __builtin_amdgcn_exp2f(-dl); resc = true;
#pragma unroll
            for (int r = 0; r < 16; ++r) { pS0[r] -= dl; pS1[r] -= dl; negm[r] = -m_run; }
        }
    }
    if (!NEXT) { }
    {
        const LAS unsigned char* vp0 = sbV + 16384 + vb;
#define AT_VF(d_, ks_) cat8(tr_read(vp0 + (ks_) * 4096 + (((d_) * 64) ^ vx)), tr_read(vp0 + (ks_) * 4096 + 2048 + (((d_) * 64) ^ vx)))
        __builtin_amdgcn_s_setprio(0);
        constexpr int PF = 3, RING = PF + 1;
        bf16x8 vfr[RING];
#pragma unroll
        for (int j = 0; j < PF; ++j) vfr[j] = AT_VF(j & 3, j >> 2);
        unsigned pt[4];
#pragma unroll
        for (int j = 0; j < 16; ++j) { const int ks = j >> 2, d = j & 3;
            if (j + PF < 16) vfr[(j + PF) % RING] = AT_VF((j + PF) & 3, (j + PF) >> 2);
            o[d] = __builtin_amdgcn_mfma_f32_32x32x16_bf16(pc[ks], vfr[j % RING], o[d], 0, 0, 0);
            if (NEXT) { if (j < 8) pt[d] = cvtpk(__builtin_amdgcn_exp2f(pS0[2 * j]), __builtin_amdgcn_exp2f(pS0[2 * j + 1]));
                        else pt[d] = cvtpk(__builtin_amdgcn_exp2f(pS1[2 * j - 16]), __builtin_amdgcn_exp2f(pS1[2 * j - 15])); }
            AT_SB();
            if (d == 3) {
                AT_RS(2 * ks); AT_RS(2 * ks + 1);
                if (NEXT) pc[ks] = __builtin_bit_cast(bf16x8, (u32x4){pt[0], pt[1], pt[2], pt[3]});
                AT_SB(); }
        }
#undef AT_VF
    }
#undef AT_RS
    l_run += rs0 + rs1;
    if (resc) {
        if (hi == 0) wsf[r32] = alpha;
        asm volatile("s_waitcnt lgkmcnt(0)" ::: "memory");
        l_run *= alpha;
#pragma unroll
        for (int r = 0; r < 16; ++r) { const float a = wsf[crow(r, hi)];
#pragma unroll
            for (int d = 0; d < 4; ++d) o[d][r] *= a;
            AT_SB(); }
    }
}
__device__ __forceinline__ void attn_unit(LAS unsigned char* lds, const bf16* DQ, const bf16* DK, const bf16* DV, const bf16* DG, bf16* YD, const float* subln_g, float lam, int b, int h, int jq, unsigned* qctr, volatile LAS unsigned* qslot) {
    int tid_ = tid_now(); asm volatile("" : "+v"(tid_));
    const int tid = tid_, lane = tid & 63, wid = __builtin_amdgcn_readfirstlane(tid >> 6), r32 = lane & 31, hi = lane >> 5, rg = wid & 3, map = wid >> 2;
    const size_t rowbase = (size_t)b * SEQ; const int q0 = jq * 128;
    f32x16 o[4];
#pragma unroll
    for (int i = 0; i < 4; ++i) o[i] = (f32x16){0.f, 0.f, 0.f, 0.f, 0.f, 0.f, 0.f, 0.f, 0.f, 0.f, 0.f, 0.f, 0.f, 0.f, 0.f, 0.f};
    float m_run = 0.f;
    const int NT = 2 * jq + 2, my_nt = 2 * jq + 1 + (rg >> 1);
    LAS float* wsf = (LAS float*)(lds + AT_WS) + wid * 64;
    unsigned kof[2], vof[2];
#pragma unroll
    for (int i = 0; i < 2; ++i) { const int key = 8 * wid + 4 * i + (lane >> 4);
        kof[i] = (unsigned)((key * 128 + ((lane & 15) ^ (key & 15)) * 8) * 2); vof[i] = (unsigned)((key * 128 + ((lane & 15) ^ ((key & 3) << 2)) * 8) * 2); }
    const char* kg = (const char*)(DK + ((size_t)(b * 8 + h) * SEQ) * 128); const char* vg = (const char*)(DV + ((size_t)(b * 8 + h) * SEQ) * 128);
    const unsigned lds0 = (unsigned)(uintptr_t)lds;
#define AT_DMA(t, slot) do { const char* sk_ = kg + (size_t)(t) * 16384; const char* sv_ = vg + (size_t)(t) * 16384; const unsigned d_ = (unsigned)__builtin_amdgcn_readfirstlane((int)(lds0 + (unsigned)((slot) * AT_SLOT + wid * 2048))); \
        glds16s(sk_, kof[0], d_); glds16s(sk_, kof[1], d_ + 1024u); glds16s(sv_, vof[0], d_ + 16384u); glds16s(sv_, vof[1], d_ + 16384u + 1024u); } while (0)
    const int koff = r32 * 256 + ((map * 128 + hi * 16) ^ ((r32 & 15) * 16));
    const int vb = (4 * hi + ((lane & 15) >> 2)) * 256 + ((lane >> 4) & 1) * 32 + (lane & 3) * 8, vx = ((lane & 15) >> 2) * 64;
    bf16x8 pa[4]; f32x16 negm; float l_run = 0.f;
    AT_DMA(0, 0); AT_DMA(1, 1); if (NT > 2) AT_DMA(2, 2);
    bf16x8 qf[4];
    { const bf16* qp = DQ + (rowbase + q0 + rg * 32 + r32) * 1024 + h * 128 + map * 64 + hi * 8;
#pragma unroll
      for (int s = 0; s < 4; ++s) qf[s] = *(const bf16x8*)(qp + s * 16); }
    asm volatile("s_waitcnt vmcnt(0)" : "+v"(qf[0]), "+v"(qf[1]), "+v"(qf[2]), "+v"(qf[3]) :: "memory");
    if (NT > 2) AT_WAIT_BAR(8); else AT_WAIT_BAR(4);
    at_first(lds, koff, qf, pa, m_run, negm);
#define AT_TOP(t_) do { if ((t_) + 2 < NT) AT_WAIT_BAR(4); else AT_WAIT_BAR(0);        \
        if ((t_) + 3 < NT) AT_DMA((t_) + 3, ((t_) + 3) & 3); } while (0)
#define AT_SLOTP(t_) (lds + ((t_) & 3) * AT_SLOT)
    for (int t = 0; t + 1 < NT; ++t) {
        AT_TOP(t);
        at_step<true, true>(AT_SLOTP(t + 1), AT_SLOTP(t), koff, r32, hi, vb, vx, qf, o, l_run, pa, m_run, negm, wsf, map, (t + 2 == NT) && (my_nt != NT));
    }
    AT_TOP(NT - 1);
    at_step<false>(AT_SLOTP(NT), AT_SLOTP(NT - 1), koff, r32, hi, vb, vx, qf, o, l_run, pa, m_run, negm, wsf, map);
#undef AT_TOP
#undef AT_SLOTP
    int te_ = tid_now(); asm volatile("" : "+v"(te_));
    const int tid2 = te_, lane2 = tid2 & 63, r32b = lane2 & 31, hib = lane2 >> 5;
    { const auto lr = __builtin_amdgcn_permlane32_swap(__float_as_uint(l_run), __float_as_uint(l_run), false, false);
      const float f = (map ? lam : 1.0f) * __builtin_amdgcn_rcpf(__uint_as_float(lr[0]) + __uint_as_float(lr[1]));
      if (hib == 0) wsf[r32b] = f;
      asm volatile("s_waitcnt lgkmcnt(0)" ::: "memory");
#pragma unroll
      for (int r = 0; r < 16; ++r) { const float a = wsf[crow(r, hib)];
#pragma unroll
          for (int d = 0; d < 4; ++d) o[d][r] *= a; } }
    LAS float* ep = (LAS float*)(lds + AT_EP);
    const int rowE = tid2 >> 2, segE = tid2 & 3;
    const size_t offE = (rowbase + q0 + rowE) * 1024 + h * 128 + segE * 32;
    u32x4 gE[4];
#pragma unroll
    for (int i = 0; i < 4; ++i) gE[i] = *(const u32x4*)(DG + offE + 8 * i);
    f32x4 sgE[8];
#pragma unroll
    for (int i = 0; i < 8; ++i) sgE[i] = *(const f32x4*)(subln_g + segE * 32 + 4 * i);
    unsigned qnext = 1u; { const unsigned z_ = 0u; if (tid2 == 0) asm volatile("global_atomic_add %0, %1, %0, %2 sc0" : "+v"(qnext) : "v"(z_), "s"(qctr) : "memory"); }
#define AT_EBAR() asm volatile("s_waitcnt lgkmcnt(0)\n\ts_barrier" ::: "memory")
    AT_EBAR();
    if (map == 1) {
#pragma unroll
        for (int r = 0; r < 16; ++r)
#pragma unroll
            for (int d = 0; d < 4; ++d) ep[(rg * 32 + crow(r, hib)) * AT_EPP + d * 32 + r32b] = o[d][r];
    }
    AT_EBAR();
    if (map == 0) {
#pragma unroll
        for (int r = 0; r < 16; ++r)
#pragma unroll
            for (int d = 0; d < 4; ++d) { LAS float* e = ep + (rg * 32 + crow(r, hib)) * AT_EPP + d * 32 + r32b; *e = o[d][r] - *e; }
    }
    AT_EBAR();
#undef AT_EBAR
    { const int row = rowE, seg = segE;
      const LAS float* e = ep + row * AT_EPP + seg * 32;
      f32x4 v[8]; float ss = 0.f;
#pragma unroll
      for (int i = 0; i < 8; ++i) { v[i] = *(const LAS f32x4*)(e + 4 * i); ss += (v[i][0] * v[i][0] + v[i][1] * v[i][1]) + (v[i][2] * v[i][2] + v[i][3] * v[i][3]); }
      ss += __shfl_xor(ss, 1); ss += __shfl_xor(ss, 2);
      const float rstd = 0.8f * __builtin_amdgcn_rsqf(ss * (1.0f / 128.0f) + 1e-6f);
      const size_t off = offE;
#pragma unroll
      for (int i = 0; i < 4; ++i) {
          const u32x4 g = gE[i];
          const f32x4 s0 = sgE[2 * i], s1 = sgE[2 * i + 1];
          const f32x4 a = v[2 * i], c = v[2 * i + 1]; u32x4 w;
          w.x = cvtpk(a[0] * rstd * s0[0] * bflo(g.x), a[1] * rstd * s0[1] * bfhi(g.x)); w.y = cvtpk(a[2] * rstd * s0[2] * bflo(g.y), a[3] * rstd * s0[3] * bfhi(g.y));
          w.z = cvtpk(c[0] * rstd * s1[0] * bflo(g.z), c[1] * rstd * s1[1] * bfhi(g.z)); w.w = cvtpk(c[2] * rstd * s1[2] * bflo(g.w), c[3] * rstd * s1[3] * bfhi(g.w));
          *(u32x4*)(YD + off + 8 * i) = w; } }
    asm volatile("s_waitcnt vmcnt(4)" : "+v"(qnext) :: "memory");
    if (tid2 == 0) qslot[0] = qnext;
    asm volatile("s_waitcnt lgkmcnt(0)\n\ts_barrier" ::: "memory");
#undef AT_DMA
}

constexpr int RT_Q = 0, RT_K0 = 32768, RT_V = 98304, RT_S = 131072, RT_SP = 144, RT_ST = 140288, RT_NG = 144384;
__device__ __forceinline__ int rt_swz(int row) { return ((row & 3) << 2) | ((row >> 2) & 3); }
__device__ __forceinline__ void ret_unit(LAS unsigned char* lds, const bf16* RQ, const bf16* RK, const bf16* RV, const bf16* RG, bf16* YR, const float* ret_g, int b, int h) {
    int tid_ = tid_now(); asm volatile("" : "+v"(tid_));
    const int tid = tid_, lane = tid & 63, wid = __builtin_amdgcn_readfirstlane(tid >> 6);
    const float lg2 = __builtin_log2f(1.0f - __builtin_exp2f(-5.0f - (4.0f / 3.0f) * (float)h));
    if (tid < 256) ((LAS float*)(lds + RT_NG))[tid] = ret_g[h * 256 + tid];
    f32x16 st[8];
#pragma unroll
    for (int T = 0; T < 8; ++T) st[T] = (f32x16){0.f, 0.f, 0.f, 0.f, 0.f, 0.f, 0.f, 0.f, 0.f, 0.f, 0.f, 0.f, 0.f, 0.f, 0.f, 0.f};
    const unsigned lds0 = (unsigned)(uintptr_t)lds;
    unsigned qko[4];
#pragma unroll
    for (int i = 0; i < 4; ++i) { const int row = 8 * wid + 2 * i + (lane >> 5), c = (lane & 31) ^ rt_swz(row); qko[i] = (unsigned)((row * 1024 + h * 256 + c * 8) * 2); }
    const unsigned vo = (unsigned)(((lane >> 2) * 1024 + h * 256 + wid * 32 + (lane & 3) * 8) * 2);
    const char* qg = (const char*)(RQ + (size_t)b * SEQ * 1024); const char* kg = (const char*)(RK + (size_t)b * SEQ * 1024); const char* vg = (const char*)(RV + (size_t)b * SEQ * 1024);
#define RT_DMA_QK(gbase, n_, ldsoff) do { const char* sb_ = (gbase) + (size_t)(n_) * (64 * 1024 * 2); const unsigned d_ = (unsigned)__builtin_amdgcn_readfirstlane((int)(lds0 + (unsigned)((ldsoff) + wid * 4096))); \
        glds16s(sb_, qko[0], d_); glds16s(sb_, qko[1], d_ + 1024u); glds16s(sb_, qko[2], d_ + 2048u); glds16s(sb_, qko[3], d_ + 3072u); } while (0)
#define RT_DMA_V(n_) do { const char* sb_ = vg + (size_t)(n_) * (64 * 1024 * 2); const unsigned d_ = (unsigned)__builtin_amdgcn_readfirstlane((int)(lds0 + (unsigned)(RT_V + wid * 4096))); \
        glds16s(sb_, vo, d_); glds16s(sb_ + 16 * 1024 * 2, vo, d_ + 1024u); glds16s(sb_ + 32 * 1024 * 2, vo, d_ + 2048u); glds16s(sb_ + 48 * 1024 * 2, vo, d_ + 3072u); } while (0)
    RT_DMA_QK(qg, 0, RT_Q); RT_DMA_QK(kg, 0, RT_K0); RT_DMA_QK(kg, 1, RT_K0 + 32768); RT_DMA_V(0);
    asm volatile("s_waitcnt vmcnt(0) lgkmcnt(0)\n\ts_barrier" ::: "memory");
    for (int n = 0; n < 64; ++n) {
        const size_t tok0 = (size_t)b * SEQ + (size_t)n * CHUNK;
        float lg = lg2; asm volatile("" : "+v"(lg));
        const float ginv = __builtin_amdgcn_exp2f(-lg);
        const int jn = n & 3;
        const int kbuf = RT_K0 + (n & 1) * 32768;
        int ln = lane; asm volatile("" : "+v"(ln));
        const int r32 = ln & 31, hi = ln >> 5;
        const LAS unsigned char* vw = lds + RT_V + wid * 4096;
        const int vaddr = (8 * hi + ((ln & 15) >> 2)) * 64 + ((ln >> 4) & 1) * 32 + (ln & 3) * 8;
        bf16x8 vf[4];
#pragma unroll
        for (int s = 0; s < 4; ++s) vf[s] = cat8(tr_read(vw + s * 1024 + vaddr), tr_read(vw + s * 1024 + vaddr + 256));
        asm volatile("s_waitcnt lgkmcnt(0)" : "+v"(vf[0]), "+v"(vf[1]), "+v"(vf[2]), "+v"(vf[3]) :: "memory");
        if (n + 1 < 64) RT_DMA_V(n + 1);
        { const int ct = wid >> 1, mt0 = 2 * (wid & 1);
          const int l15 = ln & 15, kq = ln >> 4, s1_x = (l15 & 3) * 64, s1_lo = (kq ^ (l15 >> 2)) * 16;
          f32x4 sa = (f32x4){0.f, 0.f, 0.f, 0.f}, sb = sa;
          const LAS unsigned char* qb = lds + RT_Q + (16 * ct + l15) * 512 + s1_lo;
          const LAS unsigned char* kb = lds + kbuf + (16 * mt0 + l15) * 512 + s1_lo;
#pragma unroll
          for (int s = 0; s < 8; ++s) {
              const int xo = (s * 64) ^ s1_x;
              const bf16x8 bq = *(const LAS bf16x8*)(qb + xo), ka = *(const LAS bf16x8*)(kb + xo), kc = *(const LAS bf16x8*)(kb + 16 * 512 + xo);
              sa = __builtin_amdgcn_mfma_f32_16x16x32_bf16(ka, bq, sa, 0, 0, 0);
              sb = __builtin_amdgcn_mfma_f32_16x16x32_bf16(kc, bq, sb, 0, 0, 0);
          }
          const int cabs = 16 * ct + l15;
#pragma unroll
          for (int tt = 0; tt < 2; ++tt) { const f32x4 sv = tt ? sb : sa; const int m0 = 16 * (mt0 + tt) + 4 * kq; float dv[4];
#pragma unroll
              for (int r = 0; r < 4; ++r) { const int dl = cabs - (m0 + r); dv[r] = sv[r] * __builtin_amdgcn_exp2f(lg * (float)(dl < 0 ? -dl : dl)); }
              *(LAS u32x2*)(lds + RT_S + cabs * RT_SP + m0 * 2) = (u32x2){cvtpk(dv[0], dv[1]), cvtpk(dv[2], dv[3])}; } }
        if (jn == 0) { const float g4 = __builtin_amdgcn_exp2f(256.0f * lg);
#pragma unroll
            for (int T = 0; T < 8; ++T)
#pragma unroll
                for (int r = 0; r < 16; ++r) st[T][r] *= g4; }
        f32x16 ao[2];
        ao[0] = (f32x16){0.f, 0.f, 0.f, 0.f, 0.f, 0.f, 0.f, 0.f, 0.f, 0.f, 0.f, 0.f, 0.f, 0.f, 0.f, 0.f}; ao[1] = ao[0];
        {
          int l3 = ln; asm volatile("" : "+v"(l3));
          const int q3_x = (l3 & 3) * 64, q3_y0 = ((l3 >> 5) ^ ((l3 >> 2) & 3)) * 16, q3_y1 = ((2 + (l3 >> 5)) ^ ((l3 >> 2) & 3)) * 16;
          const LAS unsigned char* q3 = lds + RT_Q + (l3 & 31) * 512;
#define RT_Q3(T_, s_, ct_) (*(const LAS bf16x8*)(q3 + (ct_) * 32 * 512 + ((s_) ? q3_y1 : q3_y0) + (((T_) * 64) ^ q3_x)))
          bf16x8 qa[2][2];
          qa[0][0] = RT_Q3(0, 0, 0); qa[0][1] = RT_Q3(0, 0, 1);
#pragma unroll
          for (int it = 0; it < 16; ++it) { const int T = it >> 1, s = it & 1, cur = it & 1, nx = cur ^ 1;
              if (it + 1 < 16) { qa[nx][0] = RT_Q3((it + 1) >> 1, (it + 1) & 1, 0); qa[nx][1] = RT_Q3((it + 1) >> 1, (it + 1) & 1, 1); }
              u32x4 w; const int bs = 8 * s;
              w.x = cvtpk(st[T][bs], st[T][bs + 1]); w.y = cvtpk(st[T][bs + 2], st[T][bs + 3]); w.z = cvtpk(st[T][bs + 4], st[T][bs + 5]); w.w = cvtpk(st[T][bs + 6], st[T][bs + 7]);
              const bf16x8 sA = __builtin_bit_cast(bf16x8, w);
              ao[0] = __builtin_amdgcn_mfma_f32_32x32x16_bf16(sA, qa[cur][0], ao[0], 0, 0, 0);
              ao[1] = __builtin_amdgcn_mfma_f32_32x32x16_bf16(sA, qa[cur][1], ao[1], 0, 0, 0);
              __builtin_amdgcn_sched_barrier(0); }
#undef RT_Q3
        }
        { const float xi0 = __builtin_amdgcn_exp2f(lg * (float)(r32 + 1 + 64 * jn)), xi1 = __builtin_amdgcn_exp2f(lg * (float)(r32 + 33 + 64 * jn));
#pragma unroll
          for (int r = 0; r < 16; ++r) { ao[0][r] *= xi0; ao[1][r] *= xi1; } }
        u32x2 gt[2][4];
#pragma unroll
        for (int ct = 0; ct < 2; ++ct)
#pragma unroll
            for (int g = 0; g < 4; ++g) gt[ct][g] = *(const u32x2*)(RG + (tok0 + 32 * ct + r32) * 1024 + h * 256 + wid * 32 + 4 * hi + 8 * g);
        asm volatile("s_waitcnt lgkmcnt(0)\n\ts_barrier" ::: "memory");
        if (n + 1 < 64) RT_DMA_QK(qg, n + 1, RT_Q);
#pragma unroll
        for (int ct = 0; ct < 2; ++ct)
#pragma unroll
            for (int s = 0; s < 4; ++s) {
                const bf16x8 sB = *(const LAS bf16x8*)(lds + RT_S + (32 * ct + r32) * RT_SP + (16 * s + 8 * hi) * 2);
                ao[ct] = __builtin_amdgcn_mfma_f32_32x32x16_bf16(vf[s], sB, ao[ct], 0, 0, 0);
            }
        LAS float* stp = (LAS float*)(lds + RT_ST);
#pragma unroll
        for (int ct = 0; ct < 2; ++ct) { float s1 = 0.f, s2 = 0.f;
#pragma unroll
            for (int r = 0; r < 16; ++r) { s1 += ao[ct][r]; s2 += ao[ct][r] * ao[ct][r]; }
            s1 += __shfl_xor(s1, 32); s2 += __shfl_xor(s2, 32);
            if (hi == 0) { stp[(wid * 64 + 32 * ct + r32) * 2] = s1; stp[(wid * 64 + 32 * ct + r32) * 2 + 1] = s2; } }
#pragma unroll
        for (int s = 0; s < 4; ++s) { u32x4 w = __builtin_bit_cast(u32x4, vf[s]);
            const float z0 = __builtin_amdgcn_exp2f(lg * (float)(63 - 16 * s - 8 * hi - 64 * (jn + 1))), z1 = z0 * ginv, z2 = z1 * ginv, z3 = z2 * ginv, z4 = z3 * ginv, z5 = z4 * ginv, z6 = z5 * ginv, z7 = z6 * ginv;
            w.x = cvtpk(bflo(w.x) * z0, bfhi(w.x) * z1); w.y = cvtpk(bflo(w.y) * z2, bfhi(w.y) * z3); w.z = cvtpk(bflo(w.z) * z4, bfhi(w.z) * z5); w.w = cvtpk(bflo(w.w) * z6, bfhi(w.w) * z7);
            vf[s] = __builtin_bit_cast(bf16x8, w); }
        {
          int l4 = ln; asm volatile("" : "+v"(l4));
          const int h4 = l4 >> 5, sw = ((l4 & 1) << 1) | ((l4 >> 1) & 1), cw = 2 * ((l4 >> 4) & 1) + (sw >> 1);
          const int k4_x = ((l4 & 15) >> 2) * 64, k4_z0 = (cw ^ ((2 * h4) & 3)) * 16 + (sw & 1) * 8, k4_z1 = (cw ^ ((2 * h4 + 1) & 3)) * 16 + (sw & 1) * 8;
          const LAS unsigned char* k4 = lds + kbuf + (8 * h4 + ((l4 & 15) >> 2)) * 512;
#define RT_K4(T_, s_) cat8(tr_read(k4 + (s_) * 8192 + k4_z0 + (((T_) * 64) ^ k4_x)), tr_read(k4 + (s_) * 8192 + 2048 + k4_z1 + (((T_) * 64) ^ k4_x)))
          bf16x8 ka[2][2];
          ka[0][0] = RT_K4(0, 0); ka[0][1] = RT_K4(0, 1);
#pragma unroll
          for (int it = 0; it < 16; ++it) { const int T = it >> 1, sp = it & 1, cur = it & 1, nx = cur ^ 1;
              if (it + 1 < 16) { ka[nx][0] = RT_K4((it + 1) >> 1, 2 * ((it + 1) & 1)); ka[nx][1] = RT_K4((it + 1) >> 1, 2 * ((it + 1) & 1) + 1); }
              st[T] = __builtin_amdgcn_mfma_f32_32x32x16_bf16(ka[cur][0], vf[2 * sp], st[T], 0, 0, 0);
              st[T] = __builtin_amdgcn_mfma_f32_32x32x16_bf16(ka[cur][1], vf[2 * sp + 1], st[T], 0, 0, 0);
              __builtin_amdgcn_sched_barrier(0); }
#undef RT_K4
        }
        asm volatile("s_waitcnt vmcnt(0) lgkmcnt(0)\n\ts_barrier" ::: "memory");
        if (n + 2 < 64) RT_DMA_QK(kg, n + 2, kbuf);
#pragma unroll
        for (int ct = 0; ct < 2; ++ct) { float s1 = 0.f, s2 = 0.f;
#pragma unroll
            for (int w8 = 0; w8 < 8; ++w8) { s1 += stp[(w8 * 64 + 32 * ct + r32) * 2]; s2 += stp[(w8 * 64 + 32 * ct + r32) * 2 + 1]; }
            const float mean = s1 * (1.0f / 256.0f), var = fmaxf(s2 * (1.0f / 256.0f) - mean * mean, 0.f), rstd = __builtin_amdgcn_rsqf(var + 1e-5f);
            const size_t tokoff = (tok0 + 32 * ct + r32) * 1024 + h * 256 + wid * 32 + 4 * hi;
#pragma unroll
            for (int g = 0; g < 4; ++g) {
                const u32x2 gv = gt[ct][g];
                const f32x4 ng = *(const LAS f32x4*)(lds + RT_NG + (wid * 32 + 8 * g + 4 * hi) * 4);
                const float y0 = (ao[ct][4 * g] - mean) * rstd * ng[0] * bflo(gv.x), y1 = (ao[ct][4 * g + 1] - mean) * rstd * ng[1] * bfhi(gv.x);
                const float y2 = (ao[ct][4 * g + 2] - mean) * rstd * ng[2] * bflo(gv.y), y3 = (ao[ct][4 * g + 3] - mean) * rstd * ng[3] * bfhi(gv.y);
                *(u32x2*)(YR + tokoff + 8 * g) = (u32x2){cvtpk(y0, y1), cvtpk(y2, y3)}; } }
    }
    asm volatile("s_waitcnt vmcnt(0) lgkmcnt(0)" ::: "memory");
    __syncthreads();
#undef RT_DMA_QK
#undef RT_DMA_V
}

__global__ void __launch_bounds__(NTHREADS, 2) fwd_megakernel(Args a) {
    extern __shared__ __attribute__((aligned(16))) unsigned char lds_raw[];
    LAS unsigned char* lds = (LAS unsigned char*)lds_raw;
    { const int t0 = threadIdx.x; if ((t0 & 63) == 0) ((volatile LAS unsigned char*)lds)[TIDTAB_OFF + hw_wave_slot()] = (unsigned char)(t0 >> 6); }
    __syncthreads();
    int tidk_ = tid_now(); asm volatile("" : "+v"(tidk_));
    const int tid = tidk_, lane = tid & 63, wave = __builtin_amdgcn_readfirstlane(tid >> 6);
    const int G = gridDim.x, blk = blockIdx.x;
    unsigned char* ws = a.ws;
    unsigned* ctl = (unsigned*)(ws + WS_CTL);
    float* modp = (float*)(ws + WS_MODP);
    bf16 *Win_t = (bf16*)(ws + WS_WIN), *Wr_t = (bf16*)(ws + WS_WR), *Wd_t = (bf16*)(ws + WS_WD), *Wo_t = (bf16*)(ws + WS_WO);
    float* ssq = (float*)(ws + WS_SSQ);
    bf16 *Hb = (bf16*)(ws + WS_H), *RQ = (bf16*)(ws + WS_RQ), *RK = (bf16*)(ws + WS_RK), *RV = (bf16*)(ws + WS_RV), *RG = (bf16*)(ws + WS_RG), *DQ = (bf16*)(ws + WS_DQ), *DK = (bf16*)(ws + WS_DK);
    bf16 *DV = (bf16*)a.out, *DG = (bf16*)a.out + (size_t)M * 1024;
    volatile LAS unsigned* MISC = (volatile LAS unsigned*)(lds + LDS_BYTES - 192);
    if (tid < 32) MISC[tid] = 0u;
    __syncthreads();
    const unsigned bar_x = (unsigned)__builtin_amdgcn_readfirstlane((int)xcd_barrier_post(ctl + CW_BAR, MISC).x);
#define GRID_BAR() do { XcdBarrier b_; { unsigned* p_ = (unsigned*)(a.ws + WS_CTL) + CW_BAR; asm volatile("" : "+s"(p_)); b_.bar = p_; } b_.x = bar_x; b_.st = (volatile LAS unsigned*)(lds + LDS_BYTES - 192); xcd_barrier(b_); } while (0)

    for (int rep_ = 0; rep_ < REP_P0; ++rep_)
    {
        LAS float* scr = (LAS float*)(lds + wave * 16384);
        constexpr int I_IN = (D / 64) * (NPROJ / 32), I_SQ = (D / 64) * (D / 32), I_MOD = 48 * 16;
        constexpr int NITEMS = I_IN + 3 * I_SQ;
        for (int it = wave * G + blk; it < I_MOD; it += NWAVES * G) p0_mod_item(a.c, a.ada_w, modp, it, lane);
        const int t_lo = (int)((long)NITEMS * blk / G), t_hi = (int)((long)NITEMS * (blk + 1) / G);
        for (;;) {
            unsigned idx = 0; if (lane == 0) idx = __hip_atomic_fetch_add((LAS unsigned*)(lds + LDS_BYTES - 192 + 80), 1u, __ATOMIC_RELAXED, __HIP_MEMORY_SCOPE_WORKGROUP);
            const int it = t_lo + __builtin_amdgcn_readfirstlane((int)idx);
            if (it >= t_hi) break;
            int r = it;
            if (r < I_IN) { p0_transpose_item<true>(a.w_in, D, NPROJ, Win_t, scr, r, lane); continue; } r -= I_IN;
            if (r < I_SQ) { p0_transpose_item<false>(a.w_br, D, D, Wr_t, scr, r, lane); continue; } r -= I_SQ;
            if (r < I_SQ) { p0_transpose_item<false>(a.w_bd, D, D, Wd_t, scr, r, lane); continue; } r -= I_SQ;
            p0_transpose_item<false>(a.w_out, D, D, Wo_t, scr, r, lane);
        }
    }
    GRID_BAR();

    for (int rep_ = 0; rep_ < REP_P1; ++rep_)
    {
        int tid = tid_now(); asm volatile("" : "+v"(tid)); const int lane = tid & 63, wave = __builtin_amdgcn_readfirstlane(tid >> 6);
        int blko = blockIdx.x; asm volatile("" : "+s"(blko));
        const int rows_per = M / G, row_lo = blko * rows_per, b = row_lo / SEQ;
        LAS float* gs = (LAS float*)(lds + 131072); LAS float* sh = gs + 1024;
        __syncthreads();
        for (int k = tid; k < 1024; k += NTHREADS) {
            gs[k] = a.pre_g[k] * (1.0f + mod_value(modp, a.ada_b, b, 1024 + k));
            sh[k] = mod_value(modp, a.ada_b, b, k);
        }
        __syncthreads();
        f32x4 vnx[2][4];
        { const f32x4* xr0 = (const f32x4*)(a.x + (size_t)(row_lo + wave) * D) + lane; const f32x4* xr1 = xr0 + (size_t)NWAVES * (D / 4);
#pragma unroll
          for (int j = 0; j < 4; ++j) { vnx[0][j] = __builtin_nontemporal_load(xr0 + 64 * j); vnx[1][j] = __builtin_nontemporal_load(xr1 + 64 * j); } }
        for (int r = wave; r < rows_per; r += 2 * NWAVES) {
            const int m0 = row_lo + r, m1 = m0 + NWAVES;
            f32x4 v[2][4]; float s0 = 0.f, s1 = 0.f;
#pragma unroll
            for (int j = 0; j < 4; ++j) { v[0][j] = vnx[0][j]; v[1][j] = vnx[1][j]; }
            if (r + 2 * NWAVES < rows_per) { const f32x4* xr0 = (const f32x4*)(a.x + (size_t)(m0 + 2 * NWAVES) * D) + lane; const f32x4* xr1 = xr0 + (size_t)NWAVES * (D / 4);
#pragma unroll
                for (int j = 0; j < 4; ++j) { vnx[0][j] = __builtin_nontemporal_load(xr0 + 64 * j); vnx[1][j] = __builtin_nontemporal_load(xr1 + 64 * j); } }
#pragma unroll
            for (int j = 0; j < 4; ++j) { s0 += (v[0][j][0] * v[0][j][0] + v[0][j][1] * v[0][j][1]) + (v[0][j][2] * v[0][j][2] + v[0][j][3] * v[0][j][3]);
                                          s1 += (v[1][j][0] * v[1][j][0] + v[1][j][1] * v[1][j][1]) + (v[1][j][2] * v[1][j][2] + v[1][j][3] * v[1][j][3]); }
            const float rstd0 = __builtin_amdgcn_rsqf(wave_sum(s0) * (1.0f / D) + 1e-6f), rstd1 = __builtin_amdgcn_rsqf(wave_sum(s1) * (1.0f / D) + 1e-6f);
            u32x2* o80 = (u32x2*)(Hb + (size_t)m0 * D) + lane; u32x2* o81 = (u32x2*)(Hb + (size_t)m1 * D) + lane;
#pragma unroll
            for (int j = 0; j < 4; ++j) { const int k = 4 * lane + 256 * j;
                const f32x4 g4 = *(const LAS f32x4*)(gs + k), s4 = *(const LAS f32x4*)(sh + k);
                o80[64 * j] = (u32x2){pk2(v[0][j][0] * rstd0 * g4[0] + s4[0], v[0][j][1] * rstd0 * g4[1] + s4[1]), pk2(v[0][j][2] * rstd0 * g4[2] + s4[2], v[0][j][3] * rstd0 * g4[3] + s4[3])};
                o81[64 * j] = (u32x2){pk2(v[1][j][0] * rstd1 * g4[0] + s4[0], v[1][j][1] * rstd1 * g4[1] + s4[1]), pk2(v[1][j][2] * rstd1 * g4[2] + s4[2], v[1][j][3] * rstd1 * g4[3] + s4[3])}; }
        }
    }
    GRID_BAR();

    for (int rep_ = 0; rep_ < REP_P2; ++rep_)
    {
        pg8::Gemm g{Hb, Win_t, M, NMIX, D}; pg8::StaticOrder S; S.init(M, NMIX, G, blk);
        pg8::EpiInProj E{RQ, RK, RV, RG, DQ, DK, DV, DG, a.pos};
        pg8::gemm_phase<pg8::EpiInProj, pg8::StaticOrder, true, true>(lds, g, S, E);
    }
    GRID_BAR();

    {
#ifndef SKIP_RET
        if (blk < BATCH * 4) ret_unit(lds, RQ, RK, RV, RG, RQ, a.ret_g, blk >> 2, blk & 3);
#endif
        int tid = tid_now(); asm volatile("" : "+v"(tid)); const int lane = tid & 63;
        float d1 = a.lq1[lane] * a.lk1[lane], d2 = a.lq2[lane] * a.lk2[lane];
        d1 = wave_sum(d1); d2 = wave_sum(d2);
        const float lam = __uint_as_float((unsigned)__builtin_amdgcn_readfirstlane((int)__float_as_uint(__expf(d1) - __expf(d2) + 0.2f)));
        volatile LAS unsigned* qslot = MISC + 16;
        __syncthreads();
        unsigned qx = bar_x & 7u;
        int hops = 0;
        if (tid == 0) qslot[0] = atomicAdd(ctl + qx, 1u);
        __syncthreads();
        for (;;) {
            unsigned idx = qslot[0];
            while (idx >= 256u && hops < 7) {
                ++hops; qx = (qx + 1u) & 7u;
                __syncthreads();
                if (tid == 0) qslot[0] = atomicAdd(ctl + qx, 1u);
                __syncthreads();
                idx = qslot[0];
            }
            if (idx >= 256u) break;
            const int jq = 31 - (int)(idx >> 3), bh = (int)qx + 8 * (int)(idx & 7);
            attn_unit(lds, DQ, DK, DV, DG, DQ, a.subln_g, lam, bh >> 3, bh & 7, jq, ctl + qx, qslot);
        }
    }
    GRID_BAR();

    for (int rep_ = 0; rep_ < REP_P4; ++rep_)
    {
        pg8::Gemm g{Hb, Win_t + (size_t)NMIX * D, M, NGATE, D}; pg8::StaticOrder S; S.init(M, NGATE, G, blk);
        pg8::EpiSigmoid E{RK, RV};
        pg8::gemm_phase<pg8::EpiSigmoid, pg8::StaticOrder, true, true>(lds, g, S, E);
    }
    static_assert(NGATE == 2 * D, "gate tiles (pm, pn) and (pm, pn + 4) must land on the workgroup that runs branch tile (pm, pn)");

    for (int rep_ = 0; rep_ < REP_P5; ++rep_)
    {
        pg8::StaticOrder S; S.init(M, D, G, blk);
        { pg8::Gemm g{RQ, Wr_t, M, D, D}; pg8::EpiGate<false> E{RK, nullptr, DK}; pg8::gemm_phase<pg8::EpiGate<false>, pg8::StaticOrder, true, true>(lds, g, S, E); }
        { pg8::Gemm g{DQ, Wd_t, M, D, D}; pg8::EpiGate<true> E{RV, DK, DK}; pg8::gemm_phase<pg8::EpiGate<true>, pg8::StaticOrder, true, true>(lds, g, S, E); }
    }
    GRID_BAR();

    for (int rep_ = 0; rep_ < REP_P6; ++rep_)
    {
        pg8::Gemm g{DK, Wo_t, M, D, D}; pg8::StaticOrder S; S.init(M, D, G, blk);
        pg8::EpiOutSsq E{Hb, ssq};
        pg8::gemm_phase<pg8::EpiOutSsq, pg8::StaticOrder, true, true>(lds, g, S, E);
    }
    GRID_BAR();

    for (int rep_ = 0; rep_ < REP_P7; ++rep_)
    {
        int tid = tid_now(); asm volatile("" : "+v"(tid)); const int lane = tid & 63, wave = __builtin_amdgcn_readfirstlane(tid >> 6);
        int blko = blockIdx.x; asm volatile("" : "+s"(blko));
        const int rows_per = M / G, row_lo = blko * rows_per, b = row_lo / SEQ;
        LAS float* gp = (LAS float*)lds;
        __syncthreads();
        for (int k = tid; k < 1024; k += NTHREADS) gp[k] = a.post_g[k] * mod_value(modp, a.ada_b, b, 2048 + k);
        __syncthreads();
        f32x4 xn[2][4]; u32x2 on[2][4]; float sn0, sn1;
#define P7_FETCH(m0_) do { const int m0f = (m0_), m1f = m0f + NWAVES; \
            const f32x4* xr0 = (const f32x4*)(a.x + (size_t)m0f * D) + lane; const f32x4* xr1 = (const f32x4*)(a.x + (size_t)m1f * D) + lane; \
            const u32x2* ob0 = (const u32x2*)(Hb + (size_t)m0f * D) + lane; const u32x2* ob1 = (const u32x2*)(Hb + (size_t)m1f * D) + lane; \
            _Pragma("unroll") for (int j = 0; j < 4; ++j) { xn[0][j] = __builtin_nontemporal_load(xr0 + 64 * j); on[0][j] = __builtin_nontemporal_load(ob0 + 64 * j); \
                                                            xn[1][j] = __builtin_nontemporal_load(xr1 + 64 * j); on[1][j] = __builtin_nontemporal_load(ob1 + 64 * j); } \
            sn0 = (lane < 16) ? ssq[(size_t)m0f * 16 + lane] : 0.f; sn1 = (lane < 16) ? ssq[(size_t)m1f * 16 + lane] : 0.f; } while (0)
        P7_FETCH(row_lo + wave);
        for (int r = wave; r < rows_per; r += 2 * NWAVES) {
            const int m0 = row_lo + r, m1 = m0 + NWAVES;
            f32x4 xv[2][4]; u32x2 ov[2][4];
#pragma unroll
            for (int j = 0; j < 4; ++j) { xv[0][j] = xn[0][j]; xv[1][j] = xn[1][j]; ov[0][j] = on[0][j]; ov[1][j] = on[1][j]; }
            const float s0 = sn0, s1 = sn1;
            if (r + 2 * NWAVES < rows_per) P7_FETCH(m0 + 2 * NWAVES);
            const float rstd0 = __builtin_amdgcn_rsqf(wave_sum(s0) * (1.0f / D) + 1e-6f), rstd1 = __builtin_amdgcn_rsqf(wave_sum(s1) * (1.0f / D) + 1e-6f);
            f32x4* yo0 = (f32x4*)(a.out + (size_t)m0 * D) + lane; f32x4* yo1 = (f32x4*)(a.out + (size_t)m1 * D) + lane;
#pragma unroll
            for (int j = 0; j < 4; ++j) { const int k = 4 * lane + 256 * j; const f32x4 g4 = *(const LAS f32x4*)(gp + k);
                f32x4 y0, y1;
                y0[0] = xv[0][j][0] + bflo(ov[0][j].x) * rstd0 * g4[0]; y0[1] = xv[0][j][1] + bfhi(ov[0][j].x) * rstd0 * g4[1]; y0[2] = xv[0][j][2] + bflo(ov[0][j].y) * rstd0 * g4[2]; y0[3] = xv[0][j][3] + bfhi(ov[0][j].y) * rstd0 * g4[3];
                y1[0] = xv[1][j][0] + bflo(ov[1][j].x) * rstd1 * g4[0]; y1[1] = xv[1][j][1] + bfhi(ov[1][j].x) * rstd1 * g4[1]; y1[2] = xv[1][j][2] + bflo(ov[1][j].y) * rstd1 * g4[2]; y1[3] = xv[1][j][3] + bfhi(ov[1][j].y) * rstd1 * g4[3];
                __builtin_nontemporal_store(y0, yo0 + 64 * j); __builtin_nontemporal_store(y1, yo1 + 64 * j); }
        }
    }
}

extern "C" void kernel_launch(void* const* d_in, const int* in_sizes, int n_in, void* d_out, int out_size, void* d_ws, size_t ws_size, hipStream_t stream) {
    static int grid = 0;
    if (grid == 0) {
        if (n_in != 17 || in_sizes[0] != M * D || out_size != M * D || ws_size < WS_END) { fprintf(stderr, "kernel_launch: unexpected shapes (n_in %d, ws %zu)\n", n_in, ws_size); grid = -1; return; }
        int dev = 0, cus = 0, per_cu = 0;
        if (hipGetDevice(&dev) != hipSuccess || hipDeviceGetAttribute(&cus, hipDeviceAttributeMultiprocessorCount, dev) != hipSuccess) { grid = -1; return; }
        if (hipFuncSetAttribute((const void*)fwd_megakernel, hipFuncAttributeMaxDynamicSharedMemorySize, LDS_BYTES) != hipSuccess) { fprintf(stderr, "kernel_launch: hipFuncSetAttribute failed\n"); grid = -1; return; }
        if (hipOccupancyMaxActiveBlocksPerMultiprocessor(&per_cu, (const void*)fwd_megakernel, NTHREADS, LDS_BYTES) != hipSuccess || per_cu < 1) { fprintf(stderr, "kernel_launch: occupancy query failed (%d)\n", per_cu); (void)hipGetLastError(); grid = -1; return; }
        grid = cus * (per_cu < 1 ? 1 : 1);
        if (grid != 256) { fprintf(stderr, "kernel_launch: built for 256 CUs, device has %d\n", cus); grid = -1; return; }
        for (int c = 0; c < grid; ++c) { pg8::StaticOrder Sg, Sb; Sg.init(M, NGATE, grid, c); Sb.init(M, D, grid, c); pg8::Unit ub, ug; bool ok = true;
            for (int i = 0; Sb.next(i, ub) && ok; ++i) { bool f0 = false, f1 = false;
                for (int k = 0; Sg.next(k, ug); ++k) { if (ug.pm == ub.pm && ug.pn == ub.pn) f0 = true; if (ug.pm == ub.pm && ug.pn == ub.pn + 4) f1 = true; }
                ok = f0 && f1; }
            if (!ok) { fprintf(stderr, "kernel_launch: gate / branch tile ownership mismatch (workgroup %d)\n", c); grid = -1; return; } }
    }
    if (grid < 0) return;
    (void)hipMemsetAsync((char*)d_ws + WS_CTL, 0, CTL_BYTES, stream);
    Args a{};
    a.x = (const float*)d_in[0]; a.c = (const float*)d_in[1]; a.pos = (const int*)d_in[2]; a.ada_w = (const float*)d_in[3]; a.ada_b = (const float*)d_in[4]; a.pre_g = (const float*)d_in[5];
    a.w_in = (const float*)d_in[6]; a.ret_g = (const float*)d_in[7]; a.lq1 = (const float*)d_in[8]; a.lk1 = (const float*)d_in[9]; a.lq2 = (const float*)d_in[10]; a.lk2 = (const float*)d_in[11];
    a.subln_g = (const float*)d_in[12]; a.w_br = (const float*)d_in[13]; a.w_bd = (const float*)d_in[14]; a.w_out = (const float*)d_in[15]; a.post_g = (const float*)d_in[16];
    a.out = (float*)d_out; a.ws = (unsigned char*)d_ws;
    void* args[] = {&a};
    const hipError_t e = hipLaunchCooperativeKernel((const void*)fwd_megakernel, dim3(grid), dim3(NTHREADS), args, LDS_BYTES, stream);
    if (e != hipSuccess) fprintf(stderr, "kernel_launch: cooperative launch failed: %s (grid %d)\n", hipGetErrorString(e), grid);
}
```
